# Optimizing an MI355X kernel written in HIP

```python
import math
import jax, jax.numpy as jnp
from jax import lax
import numpy as np

D_MODEL = 1024
BATCH = 4
SEQ = 4096
DEPTH = 4
DEC_BATCH = 128
DEC_SEQ = 8
PAST_LEN = 8192
PAGE_SIZE = 128

HEAD_DIM = 64
SWA_WIDTH = D_MODEL // 2
N_Q_HEADS = SWA_WIDTH // HEAD_DIM
N_KV_HEADS = 2
Q_PER_KV = N_Q_HEADS // N_KV_HEADS
KV_WIDTH = N_KV_HEADS * HEAD_DIM
WINDOW = 128
ROPE_THETA = 500000.0
ROT_DIM = HEAD_DIM // 4
POOL_WINDOWS = (2, 4, 8, 16)
N_POOL_GROUPS = 4
POOL_WIDTH = D_MODEL // 4
POOL_GROUP = POOL_WIDTH // N_POOL_GROUPS
POOL_STATE = max(POOL_WINDOWS) - 1
N_MEM = 256
N_X_HEADS = 4
X_WIDTH = N_X_HEADS * HEAD_DIM
N_BRANCH = 3
IN_COLS = POOL_WIDTH + SWA_WIDTH + 2 * KV_WIDTH + X_WIDTH + N_BRANCH * D_MODEL
SPLITS = (POOL_WIDTH,
          POOL_WIDTH + SWA_WIDTH,
          POOL_WIDTH + SWA_WIDTH + KV_WIDTH,
          POOL_WIDTH + SWA_WIDTH + 2 * KV_WIDTH,
          POOL_WIDTH + SWA_WIDTH + 2 * KV_WIDTH + X_WIDTH)
D_FF = 256 * math.ceil(8 * D_MODEL / 3 / 256)
ALPHA = (2 * DEPTH) ** 0.25
BETA = (8 * DEPTH) ** -0.25
LN_EPS = 1e-5

kernel_name = "hybrid_pool_swa_cross_macaron_step"

F32 = jnp.float32


def _layer_norm(x, g, b):
    xf = x.astype(F32)
    mu = jnp.mean(xf, axis=-1, keepdims=True)
    var = jnp.mean(jnp.square(xf - mu), axis=-1, keepdims=True)
    return ((xf - mu) * lax.rsqrt(var + LN_EPS) * g.astype(F32) + b.astype(F32)).astype(x.dtype)


def _swiglu(x, w_gate, w_up, w_down):
    return (jax.nn.silu(x @ w_gate) * (x @ w_up)) @ w_down


def _rope_partial(x, pos):
    half = ROT_DIM // 2
    inv_freq = jnp.power(ROPE_THETA, -jnp.arange(half, dtype=F32) * (2.0 / ROT_DIM))
    ang = pos.astype(F32)[:, None] * inv_freq[None, :]
    cos = jnp.cos(ang)[:, None, :]
    sin = jnp.sin(ang)[:, None, :]
    xr = x[..., :ROT_DIM].astype(F32)
    x1, x2 = xr[..., :half], xr[..., half:]
    rot = jnp.concatenate([x1 * cos - x2 * sin, x2 * cos + x1 * sin], axis=-1).astype(x.dtype)
    return jnp.concatenate([rot, x[..., ROT_DIM:]], axis=-1)


def _sink_attention(q, k, v, sink, mask):
    s = jnp.einsum('...qhgd,...khd->...hgqk', q, k).astype(F32) * (HEAD_DIM ** -0.5)
    s = jnp.where(mask, s, -jnp.inf)
    sink_l = sink.astype(F32).reshape(N_KV_HEADS, Q_PER_KV)[:, :, None, None]
    m = jnp.maximum(jnp.max(s, axis=-1, keepdims=True), sink_l)
    p = jnp.exp(s - m)
    denom = jnp.sum(p, axis=-1, keepdims=True) + jnp.exp(sink_l - m)
    return jnp.einsum('...hgqk,...khd->...qhgd', (p / denom).astype(v.dtype), v)


def _swa_prompt(q, k, v, sink):
    b, s = q.shape[:2]
    nb = s // WINDOW
    qb = q.reshape(b, nb, WINDOW, N_KV_HEADS, Q_PER_KV, HEAD_DIM)
    kb = k.reshape(b, nb, WINDOW, N_KV_HEADS, HEAD_DIM)
    vb = v.reshape(b, nb, WINDOW, N_KV_HEADS, HEAD_DIM)
    pad = jnp.zeros_like(kb[:, :1])
    kk = jnp.concatenate([jnp.concatenate([pad, kb[:, :-1]], axis=1), kb], axis=2)
    vv = jnp.concatenate([jnp.concatenate([pad, vb[:, :-1]], axis=1), vb], axis=2)
    i = jnp.arange(WINDOW)[:, None]
    j = jnp.arange(2 * WINDOW)[None, :]
    rel = i + WINDOW - j
    blk = jnp.arange(nb)[:, None, None]
    mask = (rel >= 0) & (rel < WINDOW) & ((blk > 0) | (j >= WINDOW))
    o = _sink_attention(qb, kk, vv, sink, mask[None, :, None, None])
    return o.reshape(b, s, SWA_WIDTH)


def _swa_sample(q, k, v, cache_k, cache_v, sink, start):
    b, l = q.shape[:2]
    nbuf = cache_k.shape[1]
    kk = jnp.concatenate([cache_k, k], axis=1)
    vv = jnp.concatenate([cache_v, v], axis=1)
    qpos = start + jnp.arange(l)
    kpos = start - nbuf + jnp.arange(nbuf + l)
    rel = qpos[:, None] - kpos[None, :]
    mask = (rel >= 0) & (rel < WINDOW) & (kpos[None, :] >= 0)
    qg = q.reshape(b, l, N_KV_HEADS, Q_PER_KV, HEAD_DIM)
    o = _sink_attention(qg, kk, vv, sink, mask)
    return o.reshape(b, l, SWA_WIDTH), kk[:, -nbuf:], vv[:, -nbuf:]


def _pool_branch(xp, prefix, start, pool_mix, pool_scale):
    b, s, _ = xp.shape
    comb = jnp.concatenate([prefix, xp], axis=1)
    cs = jnp.cumsum(comb.astype(F32), axis=1)
    cs = jnp.concatenate([jnp.zeros((b, 1, POOL_WIDTH), F32), cs], axis=1)
    pos = start + jnp.arange(s)
    means = []
    for g, w in enumerate(POOL_WINDOWS):
        lo, hi = g * POOL_GROUP, (g + 1) * POOL_GROUP
        lead = cs[:, POOL_STATE + 1:POOL_STATE + 1 + s, lo:hi]
        lag = cs[:, POOL_STATE + 1 - w:POOL_STATE + 1 - w + s, lo:hi]
        cnt = jnp.minimum(w, pos + 1).astype(F32)[None, :, None]
        means.append((lead - lag) / cnt)
    mean = jnp.concatenate(means, axis=-1)
    d = (mean - xp.astype(F32)).astype(xp.dtype).reshape(b, s, N_POOL_GROUPS, POOL_GROUP)
    y = jnp.einsum('bsgc,gcd->bsgd', d, pool_mix).reshape(b, s, POOL_WIDTH) * pool_scale
    return y, comb[:, -POOL_STATE:]


def _cross_attention(q, mem_k, mem_v):
    b, s = q.shape[:2]
    sc = jnp.einsum('bshd,bmhd->bhsm', q, mem_k).astype(F32) * (HEAD_DIM ** -0.5)
    p = jax.nn.softmax(sc, axis=-1).astype(mem_v.dtype)
    return jnp.einsum('bhsm,bmhd->bshd', p, mem_v).reshape(b, s, X_WIDTH)


def _layer(x, start, pool_prefix, cache_k, cache_v, mem_k, mem_v,
           ffn1_w_gate, ffn1_w_up, ffn1_w_down, ln1_g, ln1_b,
           w_in, pool_mix, pool_scale, attn_sink, w_br_pool, w_br_swa, w_br_cross, w_o,
           ln2_g, ln2_b, ffn2_w_gate, ffn2_w_up, ffn2_w_down, ln3_g, ln3_b):
    b, s, _ = x.shape
    positions = start + jnp.arange(s)
    x = _layer_norm(ALPHA * x + 0.5 * _swiglu(x, ffn1_w_gate, ffn1_w_up, ffn1_w_down), ln1_g, ln1_b)
    h = x @ w_in
    xp, q, k, v, xq, gates = jnp.split(h, SPLITS, axis=-1)
    q = _rope_partial(q.reshape(b, s, N_Q_HEADS, HEAD_DIM), positions)
    k = _rope_partial(k.reshape(b, s, N_KV_HEADS, HEAD_DIM), positions)
    v = v.reshape(b, s, N_KV_HEADS, HEAD_DIM)
    y_pool, new_pool = _pool_branch(xp, pool_prefix, start, pool_mix, pool_scale)
    if cache_k is None:
        y_swa = _swa_prompt(q, k, v, attn_sink)
        nbuf = min(WINDOW, s)
        new_k, new_v = k[:, -nbuf:], v[:, -nbuf:]
    else:
        y_swa, new_k, new_v = _swa_sample(q, k, v, cache_k, cache_v, attn_sink, start)
    y_x = _cross_attention(xq.reshape(b, s, N_X_HEADS, HEAD_DIM), mem_k, mem_v)
    g = jax.nn.sigmoid(gates.reshape(b, s, N_BRANCH, D_MODEL))
    merged = (g[:, :, 0] * (y_pool @ w_br_pool)
              + g[:, :, 1] * (y_swa @ w_br_swa)
              + g[:, :, 2] * (y_x @ w_br_cross))
    x = _layer_norm(ALPHA * x + merged @ w_o, ln2_g, ln2_b)
    x = _layer_norm(ALPHA * x + 0.5 * _swiglu(x, ffn2_w_gate, ffn2_w_up, ffn2_w_down), ln3_g, ln3_b)
    return x, new_k, new_v, new_pool


def setup_inputs(seed: int = 0) -> dict:
    key = jax.random.key(seed)
    ks = iter(jax.random.split(key, 40))

    def nrm(shape, scale=1.0):
        return jax.random.normal(next(ks), shape, F32) * scale

    d = {}
    d["x_prompt"] = nrm((BATCH, SEQ, D_MODEL))
    d["x_sample"] = nrm((DEC_BATCH, DEC_SEQ, D_MODEL))
    d["cache_swa_k"] = nrm((DEPTH, DEC_BATCH, min(WINDOW, PAST_LEN), N_KV_HEADS, HEAD_DIM))
    d["cache_swa_v"] = nrm((DEPTH, DEC_BATCH, min(WINDOW, PAST_LEN), N_KV_HEADS, HEAD_DIM))
    d["state_pool"] = nrm((DEPTH, DEC_BATCH, POOL_STATE, POOL_WIDTH))
    d["cache_mem_k"] = nrm((DEPTH, DEC_BATCH, N_MEM, N_X_HEADS, HEAD_DIM))
    d["cache_mem_v"] = nrm((DEPTH, DEC_BATCH, N_MEM, N_X_HEADS, HEAD_DIM))
    d["mem_prompt"] = nrm((BATCH, N_MEM, D_MODEL))
    d["w_mem_k"] = nrm((DEPTH, D_MODEL, X_WIDTH), D_MODEL ** -0.5)
    d["w_mem_v"] = nrm((DEPTH, D_MODEL, X_WIDTH), D_MODEL ** -0.5)
    d["ffn1_w_gate"] = nrm((DEPTH, D_MODEL, D_FF), D_MODEL ** -0.5)
    d["ffn1_w_up"] = nrm((DEPTH, D_MODEL, D_FF), D_MODEL ** -0.5)
    d["ffn1_w_down"] = nrm((DEPTH, D_FF, D_MODEL), BETA * D_FF ** -0.5)
    d["ln1_g"] = 1.0 + nrm((DEPTH, D_MODEL), 0.02)
    d["ln1_b"] = nrm((DEPTH, D_MODEL), 0.02)
    d["w_in"] = nrm((DEPTH, D_MODEL, IN_COLS), D_MODEL ** -0.5)
    d["pool_mix"] = nrm((DEPTH, N_POOL_GROUPS, POOL_GROUP, POOL_GROUP), POOL_GROUP ** -0.5)
    d["pool_scale"] = 1.0 + nrm((DEPTH, POOL_WIDTH), 0.1)
    d["attn_sink"] = nrm((DEPTH, N_Q_HEADS), 0.5)
    d["w_br_pool"] = nrm((DEPTH, POOL_WIDTH, D_MODEL), POOL_WIDTH ** -0.5)
    d["w_br_swa"] = nrm((DEPTH, SWA_WIDTH, D_MODEL), SWA_WIDTH ** -0.5)
    d["w_br_cross"] = nrm((DEPTH, X_WIDTH, D_MODEL), X_WIDTH ** -0.5)
    d["w_o"] = nrm((DEPTH, D_MODEL, D_MODEL), BETA * D_MODEL ** -0.5)
    d["ln2_g"] = 1.0 + nrm((DEPTH, D_MODEL), 0.02)
    d["ln2_b"] = nrm((DEPTH, D_MODEL), 0.02)
    d["ffn2_w_gate"] = nrm((DEPTH, D_MODEL, D_FF), D_MODEL ** -0.5)
    d["ffn2_w_up"] = nrm((DEPTH, D_MODEL, D_FF), D_MODEL ** -0.5)
    d["ffn2_w_down"] = nrm((DEPTH, D_FF, D_MODEL), BETA * D_FF ** -0.5)
    d["ln3_g"] = 1.0 + nrm((DEPTH, D_MODEL), 0.02)
    d["ln3_b"] = nrm((DEPTH, D_MODEL), 0.02)
    return d


def reference(x_prompt, x_sample, cache_swa_k, cache_swa_v, state_pool, cache_mem_k, cache_mem_v,
              mem_prompt, w_mem_k, w_mem_v,
              ffn1_w_gate, ffn1_w_up, ffn1_w_down, ln1_g, ln1_b,
              w_in, pool_mix, pool_scale, attn_sink, w_br_pool, w_br_swa, w_br_cross, w_o,
              ln2_g, ln2_b, ffn2_w_gate, ffn2_w_up, ffn2_w_down, ln3_g, ln3_b):
    yp, ys = x_prompt, x_sample
    bp = x_prompt.shape[0]
    pk, pv, pp, pmk, pmv = [], [], [], [], []
    sk, sv, sp = [], [], []
    for l in range(DEPTH):
        lw = (ffn1_w_gate[l], ffn1_w_up[l], ffn1_w_down[l], ln1_g[l], ln1_b[l],
              w_in[l], pool_mix[l], pool_scale[l], attn_sink[l], w_br_pool[l], w_br_swa[l],
              w_br_cross[l], w_o[l], ln2_g[l], ln2_b[l],
              ffn2_w_gate[l], ffn2_w_up[l], ffn2_w_down[l], ln3_g[l], ln3_b[l])
        mk = (mem_prompt @ w_mem_k[l]).reshape(bp, N_MEM, N_X_HEADS, HEAD_DIM)
        mv = (mem_prompt @ w_mem_v[l]).reshape(bp, N_MEM, N_X_HEADS, HEAD_DIM)
        prefix0 = jnp.zeros((bp, POOL_STATE, POOL_WIDTH), yp.dtype)
        yp, nk, nv, npool = _layer(yp, 0, prefix0, None, None, mk, mv, *lw)
        pk.append(nk); pv.append(nv); pp.append(npool); pmk.append(mk); pmv.append(mv)
        ys, nk, nv, npool = _layer(ys, PAST_LEN, state_pool[l], cache_swa_k[l], cache_swa_v[l],
                                   cache_mem_k[l], cache_mem_v[l], *lw)
        sk.append(nk); sv.append(nv); sp.append(npool)
    return (yp, ys,
            jnp.stack(pk), jnp.stack(pv), jnp.stack(pp), jnp.stack(pmk), jnp.stack(pmv),
            jnp.stack(sk), jnp.stack(sv), jnp.stack(sp))
```

```cpp
#include <hip/hip_runtime.h>
#include <hip/hip_cooperative_groups.h>
#include <cstdio>
#include <cstdint>
#include <cmath>
namespace cg = cooperative_groups;

#ifndef MK_MULTI
#define MK_MULTI 0
#endif

#define LAS __attribute__((address_space(3)))
typedef unsigned short bf16_t;
typedef short bf16x8 __attribute__((ext_vector_type(8)));
typedef short s16x4 __attribute__((ext_vector_type(4)));
typedef float f32x2 __attribute__((ext_vector_type(2)));
typedef float f32x4 __attribute__((ext_vector_type(4)));
typedef float f32x16 __attribute__((ext_vector_type(16)));
typedef unsigned u32x2 __attribute__((ext_vector_type(2)));
typedef unsigned u32x4 __attribute__((ext_vector_type(4)));
typedef __bf16 bf16x2_t __attribute__((ext_vector_type(2)));

constexpr int DM = 1024, NP = 16384, NSMP = 1024, MROWS = NP + NSMP, DEPTH = 4, DFF = 2816, INC = 4352;
constexpr int SEQ = 4096, NB = 4, DB = 128, DSEQ = 8;
constexpr float ALPHA = 1.6817928305074290f;
constexpr float LN_EPS = 1e-5f;
constexpr size_t O_Y = 0;
constexpr size_t O_PK = (size_t)MROWS * DM;
constexpr size_t O_PV = O_PK + (size_t)DEPTH * NB * 128 * 128;
constexpr size_t O_PP = O_PV + (size_t)DEPTH * NB * 128 * 128;
constexpr size_t O_PMK = O_PP + (size_t)DEPTH * NB * 15 * 256;
constexpr size_t O_PMV = O_PMK + (size_t)DEPTH * NB * 256 * 256;
constexpr size_t O_SK = O_PMV + (size_t)DEPTH * NB * 256 * 256;
constexpr size_t O_SV = O_SK + (size_t)DEPTH * DB * 128 * 128;
constexpr size_t O_SP = O_SV + (size_t)DEPTH * DB * 128 * 128;
constexpr size_t O_END = O_SP + (size_t)DEPTH * DB * 15 * 256;

constexpr size_t MiB = 1u << 20;
constexpr size_t WS_ROPE = 1 * MiB;
constexpr size_t WS_W = 2 * MiB;
constexpr size_t WL_GU1 = 0, WL_D1 = 11 * MiB, WL_IN = WL_D1 + 11 * MiB / 2, WL_BR = WL_IN + 17 * MiB / 2, WL_O = WL_BR + 2 * MiB,
                 WL_GU2 = WL_O + 2 * MiB, WL_D2 = WL_GU2 + 11 * MiB, WL_STRIDE = WL_D2 + 11 * MiB / 2;
constexpr size_t WS_WMEM = WS_W + 4 * WL_STRIDE;
constexpr size_t WS_MEMB = WS_WMEM + 4 * MiB;
constexpr size_t WS_MEMKV = WS_MEMB + 2 * MiB;
constexpr size_t WS_XB = WS_MEMKV + 4 * MiB;
constexpr size_t WS_Z = WS_XB + 34 * MiB;
constexpr size_t WS_R = WS_Z + 68 * MiB;
constexpr size_t WS_ACT = WS_R;
constexpr size_t WS_XP = WS_R;
constexpr size_t WS_Q = WS_XP + (size_t)MROWS * 256 * 2;
constexpr size_t WS_K = WS_Q + (size_t)MROWS * 512 * 2;
constexpr size_t WS_V = WS_K + (size_t)MROWS * 128 * 2;
constexpr size_t WS_XQ = WS_V + (size_t)MROWS * 128 * 2;
constexpr size_t WS_G = WS_XQ + (size_t)MROWS * 256 * 2;
constexpr size_t WS_YB = WS_G + (size_t)MROWS * 3072 * 2;
constexpr size_t WS_MG = WS_YB + (size_t)MROWS * 1024 * 2;
constexpr size_t WS_END = WS_MG + (size_t)MROWS * 1024 * 2;
static_assert(WS_ACT + (size_t)MROWS * DFF * 2 <= WS_END, "overlay");
static_assert(WS_END <= 512 * MiB, "workspace");

constexpr int LDS_BYTES = 147456;
constexpr int NPHASE = 1 + 11 * DEPTH;

struct Params { const float* in[30]; float* out; unsigned char* ws; float invf[8]; int ph_lo, ph_hi; };
typedef const Params __attribute__((address_space(4)))* KP;

__device__ __forceinline__ unsigned pk2(float lo, float hi) { f32x2 v = {lo, hi}; bf16x2_t b = __builtin_convertvector(v, bf16x2_t); return __builtin_bit_cast(unsigned, b); }
__device__ __forceinline__ float bf2f(unsigned short b) { return __uint_as_float(((unsigned)b) << 16); }
__device__ __forceinline__ u32x4 pack8(f32x4 a, f32x4 b) { u32x4 w; w.x = pk2(a[0], a[1]); w.y = pk2(a[2], a[3]); w.z = pk2(b[0], b[1]); w.w = pk2(b[2], b[3]); return w; }
__device__ __forceinline__ float wave_sum(float v) {
#pragma unroll
    for (int o = 1; o < 64; o <<= 1) v += __shfl_xor(v, o);
    return v;
}
#define LDS_WAIT() asm volatile("s_waitcnt lgkmcnt(0)" ::: "memory")

namespace pg8 {
constexpr int BM = 256, BK = 64, HALF = 128, HTB = HALF * BK * 2, STAGE_BYTES = 8 * HTB, NXCD = 8, WGM = 8;
__host__ __device__ __forceinline__ int lds_byte(int r, int c) { const int st = (r >> 4) * 2 + (c >> 5), rr = r & 15, cc = c & 31, ob = rr * 64 + cc * 2; return st * 1024 + (ob ^ (((ob >> 9) & 1) << 5)); }
__host__ __device__ __forceinline__ void stage_rc(int b, int& R, int& C) { const int st = b / 1024, sb = b % 1024, swz = sb ^ (((sb >> 9) & 1) << 5); R = (st >> 1) * 16 + swz / 64; C = (st & 1) * 32 + (swz % 64) / 2; }
__host__ __device__ __forceinline__ int perm32(int rho) { const int n = rho >> 4, i = rho & 15; return 8 * (i >> 2) + 4 * n + (i & 3); }

struct Unit { int pm, pn; };
struct Gemm { const bf16_t* A; const bf16_t* Bt; int M, N, K, lda, ldb; };

struct StaticOrder {
    int nM, nN, nwg, G, c;
    __device__ void init(int M, int N, int G_, int c_) { nM = M / BM; nN = N / BM; nwg = nM * nN; G = G_; c = c_; }
    __device__ bool next(int i, Unit& u) const {
        const long L = (long)i * G + c; if (L >= nwg) return false;
        int wgid = (int)L; { const int q = nwg / NXCD, r = nwg % NXCD, xcd = wgid % NXCD, off = wgid / NXCD; wgid = (xcd < r ? xcd * (q + 1) : r * (q + 1) + (xcd - r) * q) + off; }
        const int nig = WGM * nN, gid = wgid / nig, fm = gid * WGM, gsz = (nM - fm) < WGM ? (nM - fm) : WGM;
        u.pm = fm + ((wgid % nig) % gsz); u.pn = (wgid % nig) / gsz; return true;
    }
};

template <class Epi, bool ALIGN_EPI>
__device__ __forceinline__ void gemm_phase(LAS unsigned char* lds, const Gemm g, const StaticOrder& S, const Epi& E) {
    int tid = threadIdx.x; asm volatile("" : "+v"(tid));
    const int wid = __builtin_amdgcn_readfirstlane(tid >> 6), lane = tid & 63, wr = wid >> 2, wc = wid & 3, fr = lane & 15, fq = lane >> 4;
    const int K = g.K, nt = K / BK;
    unsigned voffA[2], voffB[2];
#pragma unroll
    for (int i = 0; i < 2; ++i) { int R, C; stage_rc(tid * 16 + i * 8192, R, C); const int Rb = Epi::PERM ? ((R & ~31) + perm32(R & 31)) : R;
        voffA[i] = (unsigned)(R * g.lda + C) * 2u; voffB[i] = (unsigned)(Rb * g.ldb + C) * 2u; }
    const size_t kstep = (size_t)(BK * 2);
    const size_t hstepA = (size_t)HALF * g.lda * 2, hstepB = (size_t)HALF * g.ldb * 2;
    const size_t tstepA = 2 * hstepA, tstepB = 2 * hstepB;
    const unsigned ldsw = (unsigned)wid * 1024u;
    const int aoff = lds_byte(wr * 64 + fr, fq * 8), boff = lds_byte(wc * 32 + fr, fq * 8);
#define PG8_SA(b, h) (((b) * 2 + (h)) * HTB)
#define PG8_SB(b, h) ((4 + (b) * 2 + (h)) * HTB)
#define PG8_STAGE(bufoff, gbase, voff) do { _Pragma("unroll") for (int _i = 0; _i < 2; ++_i) \
        __builtin_amdgcn_global_load_lds((const unsigned*)((const char*)(gbase) + (voff)[_i]), (LAS unsigned*)(lds + (bufoff) + ldsw + _i * 8192), 16, 0, 0); } while (0)
#define PG8_LDA(dst, b, h) do { _Pragma("unroll") for (int m = 0; m < 4; ++m) _Pragma("unroll") for (int k = 0; k < 2; ++k) dst[m][k] = *(const LAS bf16x8*)(lds + PG8_SA(b, h) + aoff + m * 2048 + k * 1024); } while (0)
#define PG8_LDB(dst, b, h) do { _Pragma("unroll") for (int n = 0; n < 2; ++n) _Pragma("unroll") for (int k = 0; k < 2; ++k) dst[n][k] = *(const LAS bf16x8*)(lds + PG8_SB(b, h) + boff + n * 2048 + k * 1024); } while (0)
#define PG8_MMA(ai, bj, At, Bt) do { __builtin_amdgcn_s_setprio(1); _Pragma("unroll") for (int m = 0; m < 4; ++m) _Pragma("unroll") for (int n = 0; n < 2; ++n) _Pragma("unroll") for (int k = 0; k < 2; ++k) \
        acc[ai][bj][m][n] = __builtin_amdgcn_mfma_f32_16x16x32_bf16(Bt[n][k], At[m][k], acc[ai][bj][m][n], 0, 0, 0); __builtin_amdgcn_s_setprio(0); } while (0)
#define PG8_WAIT_V(n) asm volatile("s_waitcnt vmcnt(" #n ")" ::: "memory")
#define PG8_WAIT_L(n) asm volatile("s_waitcnt lgkmcnt(" #n ")" ::: "memory")
#define PG8_BAR __builtin_amdgcn_s_barrier()
#define PG8_SCHED __builtin_amdgcn_sched_barrier(0)
    Unit cur, nxt; int ui = 0;
    if (!S.next(0, cur)) return;
    f32x4 acc[2][2][4][2];
#pragma unroll
    for (int a = 0; a < 2; ++a)
#pragma unroll
        for (int b = 0; b < 2; ++b)
#pragma unroll
            for (int m = 0; m < 4; ++m)
#pragma unroll
                for (int n = 0; n < 2; ++n) acc[a][b][m][n] = (f32x4){0.f, 0.f, 0.f, 0.f};
    bf16x8 At[4][2], B0[2][2], B1[2][2];
    const char* cA = (const char*)g.A + (size_t)cur.pm * tstepA; const char* cB = (const char*)g.Bt + (size_t)cur.pn * tstepB;
    PG8_STAGE(PG8_SB(0, 0), cB, voffB); PG8_STAGE(PG8_SB(0, 1), cB + hstepB, voffB); PG8_STAGE(PG8_SA(0, 0), cA, voffA); PG8_STAGE(PG8_SA(0, 1), cA + hstepA, voffA);
    if (wr == 1) PG8_BAR;
    PG8_WAIT_V(2); PG8_BAR;
    PG8_STAGE(PG8_SB(1, 0), cB + kstep, voffB); PG8_STAGE(PG8_SA(1, 0), cA + kstep, voffA); PG8_STAGE(PG8_SB(1, 1), cB + hstepB + kstep, voffB);
    PG8_WAIT_V(6); PG8_BAR;
    for (;;) {
        const bool has_next = S.next(ui + 1, nxt);
        const char* nA = has_next ? (const char*)g.A + (size_t)nxt.pm * tstepA : cA; const char* nB = has_next ? (const char*)g.Bt + (size_t)nxt.pn * tstepB : cB;
        for (int t = 0; t < nt; t += 2) {
            const bool last = (t == nt - 2);
            const char* a1 = cA + (size_t)(t + 1) * kstep;
            const char* a2 = last ? nA : cA + (size_t)(t + 2) * kstep; const char* b2 = last ? nB : cB + (size_t)(t + 2) * kstep;
            const char* a3 = a2 + kstep; const char* b3 = b2 + kstep;
            PG8_LDB(B0, 0, 0); PG8_LDB(B1, 0, 1); PG8_SCHED; PG8_LDA(At, 0, 0); PG8_STAGE(PG8_SA(1, 1), a1 + hstepA, voffA);
            PG8_WAIT_V(8); PG8_WAIT_L(0); PG8_BAR; PG8_MMA(0, 0, At, B0); PG8_MMA(0, 1, At, B1); PG8_BAR; PG8_SCHED;
            PG8_LDA(At, 0, 1); PG8_STAGE(PG8_SB(0, 0), b2, voffB); PG8_STAGE(PG8_SB(0, 1), b2 + hstepB, voffB); PG8_STAGE(PG8_SA(0, 0), a2, voffA);
            PG8_WAIT_V(8); PG8_WAIT_L(0); PG8_BAR; PG8_MMA(1, 0, At, B0); PG8_MMA(1, 1, At, B1); PG8_BAR; PG8_SCHED;
            PG8_LDB(B0, 1, 0); PG8_LDB(B1, 1, 1); PG8_SCHED; PG8_LDA(At, 1, 0); PG8_STAGE(PG8_SA(0, 1), a2 + hstepA, voffA);
            PG8_WAIT_V(8); PG8_WAIT_L(0); PG8_BAR; PG8_MMA(0, 0, At, B0); PG8_MMA(0, 1, At, B1); PG8_BAR; PG8_SCHED;
            PG8_LDA(At, 1, 1); PG8_STAGE(PG8_SB(1, 0), b3, voffB); PG8_STAGE(PG8_SB(1, 1), b3 + hstepB, voffB); PG8_STAGE(PG8_SA(1, 0), a3, voffA);
            PG8_WAIT_V(8); PG8_WAIT_L(0); PG8_BAR; PG8_MMA(1, 0, At, B0); PG8_MMA(1, 1, At, B1); PG8_BAR; PG8_SCHED;
        }
        if constexpr (ALIGN_EPI) { if (wr == 0) PG8_BAR; }
        E(acc, cur, wr, wc, fr, fq);
        if (!has_next) break;
#pragma unroll
        for (int a = 0; a < 2; ++a)
#pragma unroll
            for (int b = 0; b < 2; ++b)
#pragma unroll
                for (int m = 0; m < 4; ++m)
#pragma unroll
                    for (int n = 0; n < 2; ++n) acc[a][b][m][n] = (f32x4){0.f, 0.f, 0.f, 0.f};
        cur = nxt; cA = nA; cB = nB; ++ui;
        if constexpr (ALIGN_EPI) { if (wr == 1) PG8_BAR; }
    }
    PG8_WAIT_V(0);
    if constexpr (!ALIGN_EPI) { if (wr == 0) PG8_BAR; }
    PG8_BAR;
#undef PG8_SA
#undef PG8_SB
#undef PG8_STAGE
#undef PG8_LDA
#undef PG8_LDB
#undef PG8_MMA
#undef PG8_WAIT_V
#undef PG8_WAIT_L
#undef PG8_BAR
#undef PG8_SCHED
}
}

typedef const f32x4 (&AccRef)[2][2][4][2];

struct EpiGU {
    static constexpr bool PERM = true;
    bf16_t* act;
    __device__ __forceinline__ void operator()(AccRef acc, const pg8::Unit& u, int wr, int wc, int fr, int fq) const {
        asm volatile("" : "+v"(fr), "+v"(fq));
        const int row0 = u.pm * 256 + wr * 64 + fr, col0 = u.pn * 128 + wc * 32 + 8 * fq;
#pragma unroll
        for (int ai = 0; ai < 2; ++ai)
#pragma unroll
            for (int m = 0; m < 4; ++m) {
                f32x4 r[2];
#pragma unroll
                for (int n = 0; n < 2; ++n) {
                    const f32x4 gt = acc[ai][0][m][n], up = acc[ai][1][m][n];
#pragma unroll
                    for (int j = 0; j < 4; ++j) r[n][j] = gt[j] * __builtin_amdgcn_rcpf(1.0f + __expf(-gt[j])) * up[j];
                }
                *(u32x4*)(act + (size_t)(row0 + ai * 128 + m * 16) * DFF + col0) = pack8(r[0], r[1]);
            }
    }
};
struct EpiD {
    static constexpr bool PERM = false;
    const float* X; float* Z; float cs;
    __device__ __forceinline__ void operator()(AccRef acc, const pg8::Unit& u, int wr, int wc, int fr, int fq) const {
        asm volatile("" : "+v"(fr), "+v"(fq));
        const int row0 = u.pm * 256 + wr * 64 + fr, col0 = u.pn * 256 + wc * 32 + 4 * fq;
#pragma unroll
        for (int ai = 0; ai < 2; ++ai)
#pragma unroll
            for (int m = 0; m < 4; ++m) {
                const size_t off = (size_t)(row0 + ai * 128 + m * 16) * DM + col0;
#pragma unroll
                for (int bj = 0; bj < 2; ++bj)
#pragma unroll
                    for (int n = 0; n < 2; ++n) { const size_t o = off + bj * 128 + n * 16; const f32x4 x = *(const f32x4*)(X + o); *(f32x4*)(Z + o) = x * ALPHA + acc[ai][bj][m][n] * cs; }
            }
    }
};
struct EpiBR {
    static constexpr bool PERM = false;
    const bf16_t* G; float* Z; bf16_t* MG; int mode;
    __device__ __forceinline__ void operator()(AccRef acc, const pg8::Unit& u, int wr, int wc, int fr, int fq) const {
        asm volatile("" : "+v"(fr), "+v"(fq));
        const int row0 = u.pm * 256 + wr * 64 + fr, col0 = u.pn * 256 + wc * 32 + 4 * fq;
#pragma unroll
        for (int ai = 0; ai < 2; ++ai)
#pragma unroll
            for (int m = 0; m < 4; ++m) {
                const int row = row0 + ai * 128 + m * 16;
#pragma unroll
                for (int bj = 0; bj < 2; ++bj)
#pragma unroll
                    for (int n = 0; n < 2; ++n) {
                        const int c = col0 + bj * 128 + n * 16;
                        const u32x2 gw = *(const u32x2*)(G + (size_t)row * 3072 + c);
                        f32x4 gt; gt[0] = __uint_as_float(gw.x << 16); gt[1] = __uint_as_float(gw.x & 0xffff0000u); gt[2] = __uint_as_float(gw.y << 16); gt[3] = __uint_as_float(gw.y & 0xffff0000u);
                        f32x4 v = gt * acc[ai][bj][m][n];
                        float* zp = Z + (size_t)row * DM + c;
                        if (mode != 0) v += *(const f32x4*)zp;
                        if (mode != 2) *(f32x4*)zp = v;
                        else { u32x2 w; w.x = pk2(v[0], v[1]); w.y = pk2(v[2], v[3]); *(u32x2*)(MG + (size_t)row * DM + c) = w; }
                    }
            }
    }
};
struct EpiMem {
    static constexpr bool PERM = false;
    float* out; bf16_t* MKV;
    __device__ __forceinline__ void operator()(AccRef acc, const pg8::Unit& u, int wr, int wc, int fr, int fq) const {
        asm volatile("" : "+v"(fr), "+v"(fq));
        const int l = u.pn >> 1, kv = u.pn & 1;
        float* ob = out + (kv ? O_PMV : O_PMK) + (size_t)l * 1024 * 256;
        bf16_t* bb = MKV + (size_t)(l * 2 + kv) * 1024 * 256;
        const int row0 = u.pm * 256 + wr * 64 + fr, col0 = wc * 32 + 4 * fq;
#pragma unroll
        for (int ai = 0; ai < 2; ++ai)
#pragma unroll
            for (int m = 0; m < 4; ++m) {
                const size_t off = (size_t)(row0 + ai * 128 + m * 16) * 256 + col0;
#pragma unroll
                for (int bj = 0; bj < 2; ++bj)
#pragma unroll
                    for (int n = 0; n < 2; ++n) { const size_t o = off + bj * 128 + n * 16; const f32x4 v = acc[ai][bj][m][n]; *(f32x4*)(ob + o) = v; u32x2 w; w.x = pk2(v[0], v[1]); w.y = pk2(v[2], v[3]); *(u32x2*)(bb + o) = w; }
            }
    }
};
struct EpiIN {
    static constexpr bool PERM = true;
    bf16_t *XP, *Q, *Kb, *Vb, *XQ, *G; float* out; const float* rope; int l;
    __device__ __forceinline__ void operator()(AccRef acc, const pg8::Unit& u, int wr, int wc, int fr, int fq) const {
        asm volatile("" : "+v"(fr), "+v"(fq));
        const int pn = u.pn;
        const int row0 = u.pm * 256 + wr * 64 + fr;
        const int cl = wc * 32 + 8 * fq;
        const bool ropelane = ((wc & 1) == 0) && (fq < 2);
#pragma unroll
        for (int ai = 0; ai < 2; ++ai)
#pragma unroll
            for (int m = 0; m < 4; ++m) {
                const int row = row0 + ai * 128 + m * 16;
                const bool smp = row >= NP;
                const int b = smp ? ((row - NP) >> 3) : (row >> 12);
                const int t = smp ? ((row - NP) & 7) : (row & 4095);
#pragma unroll
                for (int bj = 0; bj < 2; ++bj) {
                    f32x4 v0 = acc[ai][bj][m][0], v1 = acc[ai][bj][m][1];
                    const int c = cl + 128 * bj;
                    if (pn == 0) {
                        *(u32x4*)(XP + (size_t)row * 256 + c) = pack8(v0, v1);
                        if (smp) { float* o = out + O_SP + ((size_t)(l * DB + b) * 15 + 7 + t) * 256 + c; *(f32x4*)o = v0; *(f32x4*)(o + 4) = v1; }
                        else if (t >= SEQ - 15) { float* o = out + O_PP + ((size_t)(l * NB + b) * 15 + (t - (SEQ - 15))) * 256 + c; *(f32x4*)o = v0; *(f32x4*)(o + 4) = v1; }
                    } else if (pn <= 3) {
                        const bool isv = (pn == 3) && (bj == 1);
                        if (!isv) {
                            f32x4 p0, p1;
#pragma unroll
                            for (int j = 0; j < 4; ++j) { p0[j] = __shfl_xor(v0[j], 16); p1[j] = __shfl_xor(v1[j], 16); }
                            if (ropelane) {
                                const float* tp = rope + (size_t)(smp ? SEQ + t : t) * 16;
                                const f32x4 c0 = *(const f32x4*)tp, c1 = *(const f32x4*)(tp + 4), s0 = *(const f32x4*)(tp + 8), s1 = *(const f32x4*)(tp + 12);
                                const float sg = (fq == 0) ? -1.f : 1.f;
                                v0 = v0 * c0 + p0 * s0 * sg; v1 = v1 * c1 + p1 * s1 * sg;
                            }
                        }
                        if (pn < 3) { *(u32x4*)(Q + (size_t)row * 512 + (pn - 1) * 256 + c) = pack8(v0 * 0.125f, v1 * 0.125f); }
                        else {
                            bf16_t* dst = (bj == 0) ? Kb : Vb;
                            *(u32x4*)(dst + (size_t)row * 128 + cl) = pack8(v0, v1);
                            if (smp) { float* o = out + (bj == 0 ? O_SK : O_SV) + ((size_t)(l * DB + b) * 128 + 120 + t) * 128 + cl; *(f32x4*)o = v0; *(f32x4*)(o + 4) = v1; }
                            else if (t >= SEQ - 128) { float* o = out + (bj == 0 ? O_PK : O_PV) + ((size_t)(l * NB + b) * 128 + (t - (SEQ - 128))) * 128 + cl; *(f32x4*)o = v0; *(f32x4*)(o + 4) = v1; }
                        }
                    } else if (pn == 4) {
                        *(u32x4*)(XQ + (size_t)row * 256 + c) = pack8(v0 * 0.125f, v1 * 0.125f);
                    } else {
#pragma unroll
                        for (int j = 0; j < 4; ++j) { v0[j] = __builtin_amdgcn_rcpf(1.0f + __expf(-v0[j])); v1[j] = __builtin_amdgcn_rcpf(1.0f + __expf(-v1[j])); }
                        *(u32x4*)(G + (size_t)row * 3072 + (pn - 5) * 256 + c) = pack8(v0, v1);
                    }
                }
            }
    }
};

__device__ __forceinline__ void transpose_item(const float* W, int N, int k0, int n0, bf16_t* dst, int ldd, LAS float* scr, int lane) {
#pragma unroll 8
    for (int i = 0; i < 32; ++i) { const int kk = 2 * i + (lane >> 5); scr[kk * 33 + (lane & 31)] = W[(size_t)(k0 + kk) * N + n0 + (lane & 31)]; }
    LDS_WAIT();
    const int c = lane & 7;
#pragma unroll
    for (int j = 0; j < 4; ++j) { const int n = (lane >> 3) + 8 * j; const LAS float* s = scr + (8 * c) * 33 + n;
        u32x4 o; o.x = pk2(s[0 * 33], s[1 * 33]); o.y = pk2(s[2 * 33], s[3 * 33]); o.z = pk2(s[4 * 33], s[5 * 33]); o.w = pk2(s[6 * 33], s[7 * 33]);
        *(u32x4*)(dst + (size_t)n * ldd + 8 * c) = o; }
    LDS_WAIT();
}
struct Job { const float* src; bf16_t* dst; int K, N, ldd, mode; };
__device__ __forceinline__ Job get_job(KP pp, int l, int ty) {
    const Params __attribute__((address_space(4)))& p = *pp;
    unsigned char* wl = p.ws + WS_W + (size_t)l * WL_STRIDE;
    Job j; j.mode = 0;
    switch (ty) {
    case 0: j.src = p.in[10] + (size_t)l * DM * DFF; j.dst = (bf16_t*)(wl + WL_GU1); j.K = DM; j.N = DFF; j.ldd = DM; j.mode = 1; break;
    case 1: j.src = p.in[11] + (size_t)l * DM * DFF; j.dst = (bf16_t*)(wl + WL_GU1); j.K = DM; j.N = DFF; j.ldd = DM; j.mode = 2; break;
    case 2: j.src = p.in[12] + (size_t)l * DFF * DM; j.dst = (bf16_t*)(wl + WL_D1); j.K = DFF; j.N = DM; j.ldd = DFF; break;
    case 3: j.src = p.in[15] + (size_t)l * DM * INC; j.dst = (bf16_t*)(wl + WL_IN); j.K = DM; j.N = INC; j.ldd = DM; break;
    case 4: j.src = p.in[19] + (size_t)l * 256 * DM; j.dst = (bf16_t*)(wl + WL_BR); j.K = 256; j.N = DM; j.ldd = DM; break;
    case 5: j.src = p.in[20] + (size_t)l * 512 * DM; j.dst = (bf16_t*)(wl + WL_BR) + 256; j.K = 512; j.N = DM; j.ldd = DM; break;
    case 6: j.src = p.in[21] + (size_t)l * 256 * DM; j.dst = (bf16_t*)(wl + WL_BR) + 768; j.K = 256; j.N = DM; j.ldd = DM; break;
    case 7: j.src = p.in[22] + (size_t)l * DM * DM; j.dst = (bf16_t*)(wl + WL_O); j.K = DM; j.N = DM; j.ldd = DM; break;
    case 8: j.src = p.in[25] + (size_t)l * DM * DFF; j.dst = (bf16_t*)(wl + WL_GU2); j.K = DM; j.N = DFF; j.ldd = DM; j.mode = 1; break;
    case 9: j.src = p.in[26] + (size_t)l * DM * DFF; j.dst = (bf16_t*)(wl + WL_GU2); j.K = DM; j.N = DFF; j.ldd = DM; j.mode = 2; break;
    case 10: j.src = p.in[27] + (size_t)l * DFF * DM; j.dst = (bf16_t*)(wl + WL_D2); j.K = DFF; j.N = DM; j.ldd = DFF; break;
    case 11: j.src = p.in[8] + (size_t)l * DM * 256; j.dst = (bf16_t*)(p.ws + WS_WMEM) + (size_t)(l * 2 + 0) * 256 * DM; j.K = DM; j.N = 256; j.ldd = DM; break;
    default: j.src = p.in[9] + (size_t)l * DM * 256; j.dst = (bf16_t*)(p.ws + WS_WMEM) + (size_t)(l * 2 + 1) * 256 * DM; j.K = DM; j.N = 256; j.ldd = DM; break;
    }
    return j;
}
__device__ __forceinline__ void prologue_phase(KP pp, LAS unsigned char* lds) {
    const Params __attribute__((address_space(4)))& p = *pp;
    int tid = threadIdx.x; asm volatile("" : "+v"(tid));
    const int lane = tid & 63, wave = tid >> 6;
    const int gw = blockIdx.x * 8 + wave, NGW = gridDim.x * 8;
    LAS float* scr = (LAS float*)(lds + wave * 16384);
    int base = 0;
#pragma nounroll
    for (int l = 0; l < DEPTH; ++l) {
#pragma nounroll
        for (int ty = 0; ty < 13; ++ty) {
            const Job j = get_job(pp, l, ty);
            const int nblk = j.N >> 5, nit = (j.K >> 6) * nblk;
            int it0 = (gw - base) % NGW; if (it0 < 0) it0 += NGW;
            for (int it = it0; it < nit; it += NGW) {
                const int kb = it / nblk, nb = it - kb * nblk, k0 = kb * 64, n0 = nb * 32;
                int drow = n0;
                if (j.mode) drow = 256 * (n0 >> 7) + (n0 & 127) + (j.mode == 2 ? 128 : 0);
                transpose_item(j.src, j.N, k0, n0, j.dst + (size_t)drow * j.ldd + k0, j.ldd, scr, lane);
            }
            base = (base + nit) % NGW;
        }
    }
    const int gt = blockIdx.x * 512 + tid, NGT = gridDim.x * 512;
    float* rope = (float*)(p.ws + WS_ROPE);
    for (int e = gt; e < (SEQ + DSEQ) * 8; e += NGT) {
        const int idx = e >> 3, i = e & 7; const int pos = idx < SEQ ? idx : 8192 + (idx - SEQ);
        const float angf = (float)pos * p.invf[i];
        const double a = (double)angf; const double TWO_PI = 6.283185307179586476925286766559;
        const double kq = __builtin_rint(a / TWO_PI); const double r = a - kq * TWO_PI; const double r2 = r * r;
        double sn = r, cs = 1.0, ts = r, tc = 1.0;
#pragma unroll 1
        for (int n = 1; n <= 15; ++n) { tc = -tc * r2 / (double)((2 * n - 1) * (2 * n)); ts = -ts * r2 / (double)((2 * n) * (2 * n + 1)); cs += tc; sn += ts; }
        rope[(size_t)idx * 16 + i] = (float)cs; rope[(size_t)idx * 16 + 8 + i] = (float)sn;
    }
    { const float* mp = p.in[7]; bf16_t* mb = (bf16_t*)(p.ws + WS_MEMB);
      for (int e = gt; e < 1024 * 1024 / 8; e += NGT) { const f32x4 a = *(const f32x4*)(mp + (size_t)e * 8), b = *(const f32x4*)(mp + (size_t)e * 8 + 4); *(u32x4*)(mb + (size_t)e * 8) = pack8(a, b); } }
    { bf16_t* xb = (bf16_t*)(p.ws + WS_XB); float* X = p.out + O_Y;
      for (int e = gt; e < MROWS * DM / 8; e += NGT) {
          const size_t o = (size_t)e * 8; const float* src = o < (size_t)NP * DM ? p.in[0] + o : p.in[1] + (o - (size_t)NP * DM);
          const f32x4 a = *(const f32x4*)src, b = *(const f32x4*)(src + 4); *(f32x4*)(X + o) = a; *(f32x4*)(X + o + 4) = b; *(u32x4*)(xb + o) = pack8(a, b); } }
}

__device__ __forceinline__ void ln_phase(const float* Z, float* X, bf16_t* XB, const float* g, const float* b) {
    int tid = threadIdx.x; asm volatile("" : "+v"(tid));
    const int lane = tid & 63, wave = tid >> 6;
    const int gw = blockIdx.x * 8 + wave, NGW = gridDim.x * 8;
    f32x4 gg[4], bb[4];
#pragma unroll
    for (int j = 0; j < 4; ++j) { gg[j] = *(const f32x4*)(g + 256 * j + 4 * lane); bb[j] = *(const f32x4*)(b + 256 * j + 4 * lane); }
    for (int row = gw; row < MROWS; row += NGW) {
        const f32x4* zr = (const f32x4*)(Z + (size_t)row * DM) + lane;
        f32x4 v[4]; float s = 0.f;
#pragma unroll
        for (int j = 0; j < 4; ++j) { v[j] = zr[64 * j]; s += (v[j][0] + v[j][1]) + (v[j][2] + v[j][3]); }
        const float mean = wave_sum(s) * (1.f / DM); float s2 = 0.f;
#pragma unroll
        for (int j = 0; j < 4; ++j) { v[j] = v[j] - mean; s2 += (v[j][0] * v[j][0] + v[j][1] * v[j][1]) + (v[j][2] * v[j][2] + v[j][3] * v[j][3]); }
        const float rstd = 1.f / sqrtf(wave_sum(s2) * (1.f / DM) + LN_EPS);
        f32x4* xo = (f32x4*)(X + (size_t)row * DM) + lane; u32x2* bo = (u32x2*)(XB + (size_t)row * DM) + lane;
#pragma unroll
        for (int j = 0; j < 4; ++j) { const f32x4 o = v[j] * rstd * gg[j] + bb[j]; xo[64 * j] = o; u32x2 w; w.x = pk2(o[0], o[1]); w.y = pk2(o[2], o[3]); bo[64 * j] = w; }
    }
}

constexpr int KPITCH = 144;
constexpr int VPITCH = 520;
constexpr int LDS_KS = 0, LDS_VT = 256 * KPITCH;
__device__ __forceinline__ int crow(int i, int h) { return (i & 3) + 8 * (i >> 2) + 4 * h; }
__device__ __forceinline__ bf16x8 packrow(const f32x16& x, int s) {
    u32x4 w; w.x = pk2(x[8 * s + 0], x[8 * s + 1]); w.y = pk2(x[8 * s + 2], x[8 * s + 3]); w.z = pk2(x[8 * s + 4], x[8 * s + 5]); w.w = pk2(x[8 * s + 6], x[8 * s + 7]);
    return __builtin_bit_cast(bf16x8, w);
}
#define MFMA32(a, b, c) __builtin_amdgcn_mfma_f32_32x32x16_bf16((a), (b), (c), 0, 0, 0)
template <bool MASK>
__device__ __forceinline__ void attn_qtile(const LAS unsigned char* Ks, const LAS unsigned char* Vts, int c_lo, int c_hi, const bf16_t* qptr, int qi, float m_init, float l_init, bf16_t* optr, bool do_store, int lane) {
    const int r = lane & 31, h = lane >> 5;
    bf16x8 qf[4];
#pragma unroll
    for (int s = 0; s < 4; ++s) qf[s] = *(const bf16x8*)(qptr + 16 * s + 8 * h);
    f32x16 o0, o1;
#pragma unroll
    for (int i = 0; i < 16; ++i) { o0[i] = 0.f; o1[i] = 0.f; }
    float mrun = m_init, lrun = l_init;
#pragma nounroll
    for (int c = c_lo; c < c_hi; ++c) {
        const int kb = 64 * c;
        f32x16 s0, s1;
#pragma unroll
        for (int i = 0; i < 16; ++i) { s0[i] = 0.f; s1[i] = 0.f; }
#pragma unroll
        for (int s = 0; s < 4; ++s) {
            const bf16x8 k0 = *(const LAS bf16x8*)(Ks + (kb + r) * KPITCH + 32 * s + 16 * h);
            const bf16x8 k1 = *(const LAS bf16x8*)(Ks + (kb + 32 + r) * KPITCH + 32 * s + 16 * h);
            s0 = MFMA32(k0, qf[s], s0); s1 = MFMA32(k1, qf[s], s1);
        }
        if (MASK) {
#pragma unroll
            for (int i = 0; i < 16; ++i) { const int j0 = kb + crow(i, h), j1 = j0 + 32;
                if (!(j0 > qi && j0 <= qi + 128)) s0[i] = -INFINITY;
                if (!(j1 > qi && j1 <= qi + 128)) s1[i] = -INFINITY; }
        }
        float cm = fmaxf(s0[0], s1[0]);
#pragma unroll
        for (int i = 1; i < 16; ++i) cm = fmaxf(cm, fmaxf(s0[i], s1[i]));
        cm = fmaxf(cm, __shfl_xor(cm, 32));
        const float mn = fmaxf(mrun, cm);
        const float alpha = __expf(mrun - mn);
        mrun = mn;
        float ps = 0.f;
#pragma unroll
        for (int i = 0; i < 16; ++i) { s0[i] = __expf(s0[i] - mn); s1[i] = __expf(s1[i] - mn); ps += s0[i] + s1[i]; }
        lrun = lrun * alpha + ps;
#pragma unroll
        for (int i = 0; i < 16; ++i) { o0[i] *= alpha; o1[i] *= alpha; }
        const bf16x8 p00 = packrow(s0, 0), p01 = packrow(s0, 1), p10 = packrow(s1, 0), p11 = packrow(s1, 1);
#pragma unroll
        for (int dt = 0; dt < 2; ++dt) {
            const LAS unsigned char* vrow = Vts + (32 * dt + r) * VPITCH + (kb + 4 * h) * 2;
            f32x16 o = dt ? o1 : o0;
#pragma unroll
            for (int tt = 0; tt < 2; ++tt)
#pragma unroll
                for (int s2 = 0; s2 < 2; ++s2) {
                    const s16x4 lo = *(const LAS s16x4*)(vrow + (32 * tt + 16 * s2) * 2);
                    const s16x4 hi = *(const LAS s16x4*)(vrow + (32 * tt + 16 * s2 + 8) * 2);
                    const bf16x8 vf = __builtin_shufflevector(lo, hi, 0, 1, 2, 3, 4, 5, 6, 7);
                    const bf16x8 pf = tt ? (s2 ? p11 : p10) : (s2 ? p01 : p00);
                    o = MFMA32(vf, pf, o);
                }
            if (dt) o1 = o; else o0 = o;
        }
    }
    const float lt = lrun + __shfl_xor(lrun, 32);
    const float inv = 1.0f / lt;
    if (do_store) {
#pragma unroll
        for (int g4 = 0; g4 < 4; ++g4) {
            u32x2 w0, w1;
            w0.x = pk2(o0[4 * g4 + 0] * inv, o0[4 * g4 + 1] * inv); w0.y = pk2(o0[4 * g4 + 2] * inv, o0[4 * g4 + 3] * inv);
            w1.x = pk2(o1[4 * g4 + 0] * inv, o1[4 * g4 + 1] * inv); w1.y = pk2(o1[4 * g4 + 2] * inv, o1[4 * g4 + 3] * inv);
            *(u32x2*)(optr + 8 * g4 + 4 * h) = w0;
            *(u32x2*)(optr + 32 + 8 * g4 + 4 * h) = w1;
        }
    }
}
__device__ __forceinline__ u32x4 ld8_f32(const float* p) { const f32x4 a = *(const f32x4*)p, b = *(const f32x4*)(p + 4); return pack8(a, b); }
__device__ __forceinline__ void put_kv(LAS unsigned char* Ks, LAS unsigned char* Vts, int key, int ch, u32x4 kk, u32x4 vv) {
    *(LAS u32x4*)(Ks + key * KPITCH + ch * 16) = kk;
    LAS unsigned short* vp = (LAS unsigned short*)(Vts + (ch * 8) * VPITCH + key * 2);
    constexpr int VP2 = VPITCH / 2;
    vp[0 * VP2] = (unsigned short)(vv.x & 0xffffu); vp[1 * VP2] = (unsigned short)(vv.x >> 16);
    vp[2 * VP2] = (unsigned short)(vv.y & 0xffffu); vp[3 * VP2] = (unsigned short)(vv.y >> 16);
    vp[4 * VP2] = (unsigned short)(vv.z & 0xffffu); vp[5 * VP2] = (unsigned short)(vv.z >> 16);
    vp[6 * VP2] = (unsigned short)(vv.w & 0xffffu); vp[7 * VP2] = (unsigned short)(vv.w >> 16);
}

template <int W>
__device__ __forceinline__ void pool_rows(const float (&v)[23], bool prompt, int t0, LAS float* dsm, int rbase, int col) {
#pragma unroll
    for (int i = 0; i < 8; ++i) {
        float s = 0.f;
#pragma unroll
        for (int k = 0; k < W; ++k) s += v[15 + i - k];
        const int cnt = prompt ? ((t0 + i + 1) < W ? (t0 + i + 1) : W) : W;
        dsm[(rbase + i) * 256 + col] = s / (float)cnt - v[15 + i];
    }
}
__device__ __forceinline__ void mix_phase(KP pp, int l, LAS unsigned char* lds) {
    const Params __attribute__((address_space(4)))& p = *pp;
    int tid = threadIdx.x; asm volatile("" : "+v"(tid));
    const int lane = tid & 63, wave = __builtin_amdgcn_readfirstlane(tid >> 6);
    const bf16_t* XP = (const bf16_t*)(p.ws + WS_XP); const bf16_t* Q = (const bf16_t*)(p.ws + WS_Q);
    const bf16_t* Kb = (const bf16_t*)(p.ws + WS_K); const bf16_t* Vb = (const bf16_t*)(p.ws + WS_V);
    const bf16_t* XQ = (const bf16_t*)(p.ws + WS_XQ); bf16_t* Y = (bf16_t*)(p.ws + WS_YB);
    LAS unsigned char* Ks = lds + LDS_KS; LAS unsigned char* Vts = lds + LDS_VT;
    const float* sink = p.in[18] + l * 8;
    const int r = lane & 31;
    constexpr int NU = 256 + 256 + 256 + 512 + 544;
    for (int u = blockIdx.x; u < NU; u += gridDim.x) {
        __syncthreads();
        if (u < 256) {
            const int kvh = u & 1, blk = (u >> 1) & 31, b = u >> 6;
            const int jlo = blk == 0 ? 128 : 0;
            const size_t krow0 = (size_t)b * SEQ + (blk - 1) * 128;
            for (int it = tid + jlo * 8; it < 256 * 8; it += 512) { const int key = it >> 3, ch = it & 7;
                const size_t o = (krow0 + key) * 128 + kvh * 64 + ch * 8;
                put_kv(Ks, Vts, key, ch, *(const u32x4*)(Kb + o), *(const u32x4*)(Vb + o)); }
            __syncthreads();
#pragma nounroll
            for (int q2 = 0; q2 < 2; ++q2) {
                const int qt = wave * 2 + q2, g = qt >> 2, i0 = (qt & 3) * 32;
                int c_lo = i0 >= 64 ? 1 : 0, c_hi = i0 >= 64 ? 4 : 3; if (blk == 0) c_lo = 2;
                const size_t row = (size_t)b * SEQ + blk * 128 + i0 + r;
                const int hq = kvh * 4 + g;
                attn_qtile<true>(Ks, Vts, c_lo, c_hi, Q + row * 512 + hq * 64, i0 + r, sink[hq], (lane < 32) ? 1.f : 0.f, Y + row * 1024 + 256 + hq * 64, true, lane);
            }
        } else if (u < 512) {
            const int v = u - 256, head = v & 3, qb = (v >> 2) & 15, b = v >> 6;
            const bf16_t* mk = (const bf16_t*)(p.ws + WS_MEMKV) + (size_t)(l * 2 + 0) * 1024 * 256 + (size_t)b * 256 * 256 + head * 64;
            const bf16_t* mv = (const bf16_t*)(p.ws + WS_MEMKV) + (size_t)(l * 2 + 1) * 1024 * 256 + (size_t)b * 256 * 256 + head * 64;
            for (int it = tid; it < 256 * 8; it += 512) { const int key = it >> 3, ch = it & 7; const size_t o = (size_t)key * 256 + ch * 8;
                put_kv(Ks, Vts, key, ch, *(const u32x4*)(mk + o), *(const u32x4*)(mv + o)); }
            __syncthreads();
            const size_t row = (size_t)b * SEQ + qb * 256 + wave * 32 + r;
            attn_qtile<false>(Ks, Vts, 0, 4, XQ + row * 256 + head * 64, 0, -INFINITY, 0.f, Y + row * 1024 + 768 + head * 64, true, lane);
        } else if (u < 768) {
            const int v = u - 512, kvh = v & 1, b = v >> 1;
            const float* ck = p.in[2] + ((size_t)(l * DB + b) * 128) * 128 + kvh * 64;
            const float* cv = p.in[3] + ((size_t)(l * DB + b) * 128) * 128 + kvh * 64;
            float* ok = p.out + O_SK + ((size_t)(l * DB + b) * 128) * 128 + kvh * 64;
            float* ov = p.out + O_SV + ((size_t)(l * DB + b) * 128) * 128 + kvh * 64;
            for (int it = tid; it < 192 * 8; it += 512) { const int key = it >> 3, ch = it & 7;
                u32x4 kk = (u32x4){0u, 0u, 0u, 0u}, vv = (u32x4){0u, 0u, 0u, 0u};
                if (key < 128) {
                    const size_t o = (size_t)key * 128 + ch * 8;
                    const f32x4 ka = *(const f32x4*)(ck + o), kb2 = *(const f32x4*)(ck + o + 4), va = *(const f32x4*)(cv + o), vb2 = *(const f32x4*)(cv + o + 4);
                    kk = pack8(ka, kb2); vv = pack8(va, vb2);
                    if (key >= 8) { const size_t oo = (size_t)(key - 8) * 128 + ch * 8; *(f32x4*)(ok + oo) = ka; *(f32x4*)(ok + oo + 4) = kb2; *(f32x4*)(ov + oo) = va; *(f32x4*)(ov + oo + 4) = vb2; }
                } else if (key < 136) {
                    const size_t o = ((size_t)NP + b * 8 + (key - 128)) * 128 + kvh * 64 + ch * 8;
                    kk = *(const u32x4*)(Kb + o); vv = *(const u32x4*)(Vb + o);
                }
                put_kv(Ks, Vts, key, ch, kk, vv); }
            __syncthreads();
            if (wave == 0) {
                const int g = r >> 3, t = r & 7, hq = kvh * 4 + g;
                const size_t row = (size_t)NP + b * 8 + t;
                attn_qtile<true>(Ks, Vts, 0, 3, Q + row * 512 + hq * 64, t, sink[hq], (lane < 32) ? 1.f : 0.f, Y + row * 1024 + 256 + hq * 64, true, lane);
            }
        } else if (u < 1280) {
            const int v = u - 768, head = v & 3, b = v >> 2;
            const float* mk = p.in[5] + ((size_t)(l * DB + b) * 256) * 256 + head * 64;
            const float* mv = p.in[6] + ((size_t)(l * DB + b) * 256) * 256 + head * 64;
            for (int it = tid; it < 256 * 8; it += 512) { const int key = it >> 3, ch = it & 7; const size_t o = (size_t)key * 256 + ch * 8;
                put_kv(Ks, Vts, key, ch, ld8_f32(mk + o), ld8_f32(mv + o)); }
            __syncthreads();
            if (wave == 0) {
                const size_t row = (size_t)NP + b * 8 + (r & 7);
                attn_qtile<false>(Ks, Vts, 0, 4, XQ + row * 256 + head * 64, 0, -INFINITY, 0.f, Y + row * 1024 + 768 + head * 64, r < 8, lane);
            }
        } else {
            const int pc = u - 1280;
            LAS float* dsm = (LAS float*)lds;
            const int col = tid & 255, sub = tid >> 8, grp = col >> 6;
#pragma nounroll
            for (int gi = 0; gi < 2; ++gi) {
                const int g8 = sub * 2 + gi; const int R0 = pc * 32 + g8 * 8;
                float v[23]; bool prompt = R0 < NP; int t0 = 0;
                if (prompt) {
                    t0 = R0 & (SEQ - 1);
#pragma unroll
                    for (int k = 0; k < 23; ++k) v[k] = (t0 - 15 + k >= 0) ? bf2f(XP[(size_t)(R0 - 15 + k) * 256 + col]) : 0.f;
                } else {
                    const int sb = (R0 - NP) >> 3;
                    const float* sp = p.in[4] + ((size_t)(l * DB + sb) * 15) * 256 + col;
#pragma unroll
                    for (int k = 0; k < 15; ++k) v[k] = sp[(size_t)k * 256];
#pragma unroll
                    for (int k = 0; k < 8; ++k) v[15 + k] = bf2f(XP[(size_t)(R0 + k) * 256 + col]);
                    float* op = p.out + O_SP + ((size_t)(l * DB + sb) * 15) * 256 + col;
#pragma unroll
                    for (int k = 0; k < 7; ++k) op[(size_t)k * 256] = v[8 + k];
                }
                if (grp == 0) pool_rows<2>(v, prompt, t0, dsm, g8 * 8, col);
                else if (grp == 1) pool_rows<4>(v, prompt, t0, dsm, g8 * 8, col);
                else if (grp == 2) pool_rows<8>(v, prompt, t0, dsm, g8 * 8, col);
                else pool_rows<16>(v, prompt, t0, dsm, g8 * 8, col);
            }
            __syncthreads();
            const float* pm = p.in[16] + ((size_t)(l * 4 + grp) * 64) * 64 + (col & 63);
            float wreg[64];
#pragma unroll
            for (int c = 0; c < 64; ++c) wreg[c] = pm[c * 64];
            const float psc = p.in[17][l * 256 + col];
#pragma nounroll
            for (int rr = 0; rr < 16; ++rr) {
                const int row = sub * 16 + rr;
                const LAS f32x4* dp = (const LAS f32x4*)(dsm + row * 256 + grp * 64);
                float a = 0.f;
#pragma unroll
                for (int c4 = 0; c4 < 16; ++c4) { const f32x4 d = dp[c4]; a += d[0] * wreg[4 * c4] + d[1] * wreg[4 * c4 + 1] + d[2] * wreg[4 * c4 + 2] + d[3] * wreg[4 * c4 + 3]; }
                const unsigned w = pk2(a * psc, 0.f);
                Y[(size_t)(pc * 32 + row) * 1024 + col] = (bf16_t)(w & 0xffffu);
            }
        }
    }
}

__global__ void __launch_bounds__(512, 2) fwd_kernel(Params p_unused) {
    extern __shared__ __attribute__((aligned(16))) unsigned char lds_raw[];
    LAS unsigned char* lds = (LAS unsigned char*)lds_raw;
    const int G = gridDim.x, bx = blockIdx.x;
    int ph_lo, ph_hi;
    { KP pp0 = (KP)__builtin_amdgcn_kernarg_segment_ptr(); ph_lo = pp0->ph_lo; ph_hi = pp0->ph_hi; }
#pragma nounroll
    for (int ph = ph_lo; ph < ph_hi; ++ph) {
        if (ph > ph_lo) cg::this_grid().sync();
        KP pp = (KP)__builtin_amdgcn_kernarg_segment_ptr(); asm volatile("" : "+s"(pp));
        const Params __attribute__((address_space(4)))& p = *pp;
        if (ph == 0) { prologue_phase(pp, lds); continue; }
        float* X = p.out + O_Y;
        bf16_t* XB = (bf16_t*)(p.ws + WS_XB); float* Z = (float*)(p.ws + WS_Z);
        bf16_t* ACT = (bf16_t*)(p.ws + WS_ACT);
        const int l = (ph - 1) / 11, sp = (ph - 1) % 11;
        unsigned char* wl = p.ws + WS_W + (size_t)l * WL_STRIDE;
        if (sp == 0 || sp == 8) {
            pg8::Gemm g{XB, (const bf16_t*)(wl + (sp == 0 ? WL_GU1 : WL_GU2)), MROWS, 2 * DFF, DM, DM, DM};
            pg8::StaticOrder S; S.init(MROWS, 2 * DFF, G, bx);
            EpiGU E{ACT};
            pg8::gemm_phase<EpiGU, true>(lds, g, S, E);
            if (ph == 1 && bx >= G - 32) {
                pg8::Gemm g2{(const bf16_t*)(p.ws + WS_MEMB), (const bf16_t*)(p.ws + WS_WMEM), 1024, 2048, DM, DM, DM};
                pg8::StaticOrder S2; S2.init(1024, 2048, 32, bx - (G - 32));
                EpiMem E2{p.out, (bf16_t*)(p.ws + WS_MEMKV)};
                pg8::gemm_phase<EpiMem, true>(lds, g2, S2, E2);
            }
        } else if (sp == 1 || sp == 9 || sp == 6) {
            pg8::Gemm g;
            if (sp == 6) g = pg8::Gemm{(const bf16_t*)(p.ws + WS_MG), (const bf16_t*)(wl + WL_O), MROWS, DM, DM, DM, DM};
            else g = pg8::Gemm{ACT, (const bf16_t*)(wl + (sp == 1 ? WL_D1 : WL_D2)), MROWS, DM, DFF, DFF, DFF};
            pg8::StaticOrder S; S.init(MROWS, DM, G, bx);
            EpiD E{X, Z, sp == 6 ? 1.0f : 0.5f};
            pg8::gemm_phase<EpiD, true>(lds, g, S, E);
        } else if (sp == 2 || sp == 7 || sp == 10) {
            const int gi = sp == 2 ? 13 : (sp == 7 ? 23 : 28);
            ln_phase(Z, X, XB, p.in[gi] + l * DM, p.in[gi + 1] + l * DM);
        } else if (sp == 3) {
            pg8::Gemm g{XB, (const bf16_t*)(wl + WL_IN), MROWS, INC, DM, DM, DM};
            pg8::StaticOrder S; S.init(MROWS, INC, G, bx);
            EpiIN E{(bf16_t*)(p.ws + WS_XP), (bf16_t*)(p.ws + WS_Q), (bf16_t*)(p.ws + WS_K), (bf16_t*)(p.ws + WS_V), (bf16_t*)(p.ws + WS_XQ), (bf16_t*)(p.ws + WS_G), p.out, (const float*)(p.ws + WS_ROPE), l};
            pg8::gemm_phase<EpiIN, true>(lds, g, S, E);
        } else if (sp == 4) {
            mix_phase(pp, l, lds);
        } else {
#pragma nounroll
            for (int b = 0; b < 3; ++b) {
                const int koff = b == 0 ? 0 : (b == 1 ? 256 : 768), kk = b == 1 ? 512 : 256;
                pg8::Gemm g{(const bf16_t*)(p.ws + WS_YB) + koff, (const bf16_t*)(wl + WL_BR) + koff, MROWS, DM, kk, DM, DM};
                pg8::StaticOrder S; S.init(MROWS, DM, G, bx);
                EpiBR E{(const bf16_t*)(p.ws + WS_G) + b * 1024, Z, (bf16_t*)(p.ws + WS_MG), b};
                pg8::gemm_phase<EpiBR, true>(lds, g, S, E);
            }
        }
    }
}

extern "C" void kernel_launch(void* const* d_in, const int* in_sizes, int n_in, void* d_out, int out_size, void* d_ws, size_t ws_size, hipStream_t stream) {
    static int grid = 0;
    if (grid == 0) {
        if (n_in != 30 || (size_t)out_size != O_END || ws_size < WS_END) { fprintf(stderr, "kernel_launch: unexpected shapes: n_in %d out %d ws %zu (need %zu)\n", n_in, out_size, ws_size, (size_t)WS_END); grid = -1; return; }
        int dev = 0, cus = 0, per_cu = 0;
        hipGetDevice(&dev); hipDeviceGetAttribute(&cus, hipDeviceAttributeMultiprocessorCount, dev);
        if (hipFuncSetAttribute((const void*)fwd_kernel, hipFuncAttributeMaxDynamicSharedMemorySize, LDS_BYTES) != hipSuccess) { fprintf(stderr, "kernel_launch: hipFuncSetAttribute failed\n"); grid = -1; return; }
        hipOccupancyMaxActiveBlocksPerMultiprocessor(&per_cu, (const void*)fwd_kernel, 512, LDS_BYTES);
        (void)hipGetLastError();
        if (per_cu < 1) { fprintf(stderr, "kernel_launch: occupancy query says %d blocks per CU\n", per_cu); per_cu = 1; }
        grid = cus;
    }
    if (grid < 0) return;
    Params p{};
    for (int i = 0; i < 30; ++i) p.in[i] = (const float*)d_in[i];
    p.out = (float*)d_out; p.ws = (unsigned char*)d_ws;
    for (int i = 0; i < 8; ++i) p.invf[i] = powf(500000.0f, -(float)i * 0.125f);
#if MK_MULTI
    for (int ph = 0; ph < NPHASE; ++ph) { p.ph_lo = ph; p.ph_hi = ph + 1; hipLaunchKernelGGL(fwd_kernel, dim3(grid), dim3(512), LDS_BYTES, stream, p); }
#else
    p.ph_lo = 0; p.ph_hi = NPHASE;
    void* args[] = {&p};
    hipError_t e = hipLaunchCooperativeKernel((const void*)fwd_kernel, dim3(grid), dim3(512), args, LDS_BYTES, stream);
    if (e != hipSuccess) fprintf(stderr, "kernel_launch: cooperative launch failed: %s (grid %d)\n", hipGetErrorString(e), grid);
#endif
}
```

```cpp
#include <hip/hip_runtime.h>
#include <hip/hip_cooperative_groups.h>
#include <cstdio>
#include <cstdint>
#include <cmath>
namespace cg = cooperative_groups;

#ifndef MK_MULTI
#define MK_MULTI 0
#endif

#ifndef REP_MASK
#define REP_MASK 0
#endif
#define LAS __attribute__((address_space(3)))
typedef unsigned short bf16_t;
typedef short bf16x8 __attribute__((ext_vector_type(8)));
typedef short s16x4 __attribute__((ext_vector_type(4)));
typedef float f32x2 __attribute__((ext_vector_type(2)));
typedef float f32x4 __attribute__((ext_vector_type(4)));
typedef float f32x16 __attribute__((ext_vector_type(16)));
typedef unsigned u32x2 __attribute__((ext_vector_type(2)));
typedef unsigned u32x4 __attribute__((ext_vector_type(4)));
typedef __bf16 bf16x2_t __attribute__((ext_vector_type(2)));

constexpr int DM = 1024, NP = 16384, NSMP = 1024, MROWS = NP + NSMP, DEPTH = 4, DFF = 2816, INC = 4352;
constexpr int SEQ = 4096, NB = 4, DB = 128, DSEQ = 8;
constexpr float ALPHA = 1.6817928305074290f;
constexpr float LN_EPS = 1e-5f;
constexpr size_t O_Y = 0;
constexpr size_t O_PK = (size_t)MROWS * DM;
constexpr size_t O_PV = O_PK + (size_t)DEPTH * NB * 128 * 128;
constexpr size_t O_PP = O_PV + (size_t)DEPTH * NB * 128 * 128;
constexpr size_t O_PMK = O_PP + (size_t)DEPTH * NB * 15 * 256;
constexpr size_t O_PMV = O_PMK + (size_t)DEPTH * NB * 256 * 256;
constexpr size_t O_SK = O_PMV + (size_t)DEPTH * NB * 256 * 256;
constexpr size_t O_SV = O_SK + (size_t)DEPTH * DB * 128 * 128;
constexpr size_t O_SP = O_SV + (size_t)DEPTH * DB * 128 * 128;
constexpr size_t O_END = O_SP + (size_t)DEPTH * DB * 15 * 256;

constexpr size_t MiB = 1u << 20;
constexpr size_t WS_ROPE = 1 * MiB;
constexpr size_t WS_W = 2 * MiB;
constexpr size_t WL_GU1 = 0, WL_D1 = 11 * MiB, WL_IN = WL_D1 + 11 * MiB / 2, WL_BR = WL_IN + 17 * MiB / 2, WL_O = WL_BR + 2 * MiB,
                 WL_GU2 = WL_O + 2 * MiB, WL_D2 = WL_GU2 + 11 * MiB, WL_STRIDE = WL_D2 + 11 * MiB / 2;
constexpr size_t WS_WMEM = WS_W + 4 * WL_STRIDE;
constexpr size_t WS_MEMB = WS_WMEM + 4 * MiB;
constexpr size_t WS_MEMKV = WS_MEMB + 2 * MiB;
constexpr size_t WS_XB = WS_MEMKV + 4 * MiB;
constexpr size_t WS_Z = WS_XB + 34 * MiB;
constexpr size_t WS_R = WS_Z + 68 * MiB;
constexpr size_t WS_ACT = WS_R;
constexpr size_t WS_XP = WS_R;
constexpr size_t WS_Q = WS_XP + (size_t)MROWS * 256 * 2;
constexpr size_t WS_K = WS_Q + (size_t)MROWS * 512 * 2;
constexpr size_t WS_V = WS_K + (size_t)MROWS * 128 * 2;
constexpr size_t WS_XQ = WS_V + (size_t)MROWS * 128 * 2;
constexpr size_t WS_G = WS_XQ + (size_t)MROWS * 256 * 2;
constexpr size_t WS_YB = WS_G + (size_t)MROWS * 3072 * 2;
constexpr size_t WS_MG = WS_YB + (size_t)MROWS * 1024 * 2;
constexpr size_t WS_END = WS_MG + (size_t)MROWS * 1024 * 2;
static_assert(WS_ACT + (size_t)MROWS * DFF * 2 <= WS_END, "overlay");
static_assert(WS_END <= 512 * MiB, "workspace");

constexpr int LDS_BYTES = 147456;
constexpr int NPHASE = 1 + 11 * DEPTH;

struct Params { const float* in[30]; float* out; unsigned char* ws; float invf[8]; int ph_lo, ph_hi; };
typedef const Params __attribute__((address_space(4)))* KP;

__device__ __forceinline__ unsigned pk2(float lo, float hi) { f32x2 v = {lo, hi}; bf16x2_t b = __builtin_convertvector(v, bf16x2_t); return __builtin_bit_cast(unsigned, b); }
__device__ __forceinline__ float bf2f(unsigned short b) { return __uint_as_float(((unsigned)b) << 16); }
__device__ __forceinline__ u32x4 pack8(f32x4 a, f32x4 b) { u32x4 w; w.x = pk2(a[0], a[1]); w.y = pk2(a[2], a[3]); w.z = pk2(b[0], b[1]); w.w = pk2(b[2], b[3]); return w; }
__device__ __forceinline__ float wave_sum(float v) {
#pragma unroll
    for (int o = 1; o < 64; o <<= 1) v += __shfl_xor(v, o);
    return v;
}
#define LDS_WAIT() asm volatile("s_waitcnt lgkmcnt(0)" ::: "memory")

namespace pg8 {
constexpr int BM = 256, BK = 64, HALF = 128, HTB = HALF * BK * 2, STAGE_BYTES = 8 * HTB, NXCD = 8, WGM = 8;
__host__ __device__ __forceinline__ int lds_byte(int r, int c) { const int st = (r >> 4) * 2 + (c >> 5), rr = r & 15, cc = c & 31, ob = rr * 64 + cc * 2; return st * 1024 + (ob ^ (((ob >> 9) & 1) << 5)); }
__host__ __device__ __forceinline__ void stage_rc(int b, int& R, int& C) { const int st = b / 1024, sb = b % 1024, swz = sb ^ (((sb >> 9) & 1) << 5); R = (st >> 1) * 16 + swz / 64; C = (st & 1) * 32 + (swz % 64) / 2; }
__host__ __device__ __forceinline__ int perm32(int rho) { const int n = rho >> 4, i = rho & 15; return 8 * (i >> 2) + 4 * n + (i & 3); }

struct Unit { int pm, pn; };
struct Gemm { const bf16_t* A; const bf16_t* Bt; int M, N, K, lda, ldb; };

struct StaticOrder {
    int nM, nN, nwg, G, c;
    __device__ void init(int M, int N, int G_, int c_) { nM = M / BM; nN = N / BM; nwg = nM * nN; G = G_; c = c_; }
    __device__ bool next(int i, Unit& u) const {
        const long L = (long)i * G + c; if (L >= nwg) return false;
        int wgid = (int)L; { const int q = nwg / NXCD, r = nwg % NXCD, xcd = wgid % NXCD, off = wgid / NXCD; wgid = (xcd < r ? xcd * (q + 1) : r * (q + 1) + (xcd - r) * q) + off; }
        const int nig = WGM * nN, gid = wgid / nig, fm = gid * WGM, gsz = (nM - fm) < WGM ? (nM - fm) : WGM;
        u.pm = fm + ((wgid % nig) % gsz); u.pn = (wgid % nig) / gsz; return true;
    }
};

template <class Epi, bool ALIGN_EPI>
__device__ __forceinline__ void gemm_phase(LAS unsigned char* lds, const Gemm g, const StaticOrder& S, const Epi& E) {
    int tid = threadIdx.x; asm volatile("" : "+v"(tid));
    const int wid = __builtin_amdgcn_readfirstlane(tid >> 6), lane = tid & 63, wr = wid >> 2, wc = wid & 3, fr = lane & 15, fq = lane >> 4;
    const int K = g.K, nt = K / BK;
    unsigned voffA[2], voffB[2];
#pragma unroll
    for (int i = 0; i < 2; ++i) { int R, C; stage_rc(tid * 16 + i * 8192, R, C); const int Rb = Epi::PERM ? ((R & ~31) + perm32(R & 31)) : R;
        voffA[i] = (unsigned)(R * g.lda + C) * 2u; voffB[i] = (unsigned)(Rb * g.ldb + C) * 2u; }
    const size_t kstep = (size_t)(BK * 2);
    const size_t hstepA = (size_t)HALF * g.lda * 2, hstepB = (size_t)HALF * g.ldb * 2;
    const size_t tstepA = 2 * hstepA, tstepB = 2 * hstepB;
    const unsigned ldsw = (unsigned)wid * 1024u;
    const int aoff = lds_byte(wr * 64 + fr, fq * 8), boff = lds_byte(wc * 32 + fr, fq * 8);
#define PG8_SA(b, h) (((b) * 2 + (h)) * HTB)
#define PG8_SB(b, h) ((4 + (b) * 2 + (h)) * HTB)
#define PG8_STAGE(bufoff, gbase, voff) do { _Pragma("unroll") for (int _i = 0; _i < 2; ++_i) \
        __builtin_amdgcn_global_load_lds((const unsigned*)((const char*)(gbase) + (voff)[_i]), (LAS unsigned*)(lds + (bufoff) + ldsw + _i * 8192), 16, 0, 0); } while (0)
#define PG8_LDA(dst, b, h) do { _Pragma("unroll") for (int m = 0; m < 4; ++m) _Pragma("unroll") for (int k = 0; k < 2; ++k) dst[m][k] = *(const LAS bf16x8*)(lds + PG8_SA(b, h) + aoff + m * 2048 + k * 1024); } while (0)
#define PG8_LDB(dst, b, h) do { _Pragma("unroll") for (int n = 0; n < 2; ++n) _Pragma("unroll") for (int k = 0; k < 2; ++k) dst[n][k] = *(const LAS bf16x8*)(lds + PG8_SB(b, h) + boff + n * 2048 + k * 1024); } while (0)
#define PG8_MMA(ai, bj, At, Bt) do { __builtin_amdgcn_s_setprio(1); _Pragma("unroll") for (int m = 0; m < 4; ++m) _Pragma("unroll") for (int n = 0; n < 2; ++n) _Pragma("unroll") for (int k = 0; k < 2; ++k) \
        acc[ai][bj][m][n] = __builtin_amdgcn_mfma_f32_16x16x32_bf16(Bt[n][k], At[m][k], acc[ai][bj][m][n], 0, 0, 0); __builtin_amdgcn_s_setprio(0); } while (0)
#define PG8_WAIT_V(n) asm volatile("s_waitcnt vmcnt(" #n ")" ::: "memory")
#define PG8_WAIT_L(n) asm volatile("s_waitcnt lgkmcnt(" #n ")" ::: "memory")
#define PG8_BAR __builtin_amdgcn_s_barrier()
#define PG8_SCHED __builtin_amdgcn_sched_barrier(0)
    Unit cur, nxt; int ui = 0;
    if (!S.next(0, cur)) return;
    f32x4 acc[2][2][4][2];
#pragma unroll
    for (int a = 0; a < 2; ++a)
#pragma unroll
        for (int b = 0; b < 2; ++b)
#pragma unroll
            for (int m = 0; m < 4; ++m)
#pragma unroll
                for (int n = 0; n < 2; ++n) acc[a][b][m][n] = (f32x4){0.f, 0.f, 0.f, 0.f};
    bf16x8 At[4][2], B0[2][2], B1[2][2];
    const char* cA = (const char*)g.A + (size_t)cur.pm * tstepA; const char* cB = (const char*)g.Bt + (size_t)cur.pn * tstepB;
    PG8_STAGE(PG8_SB(0, 0), cB, voffB); PG8_STAGE(PG8_SB(0, 1), cB + hstepB, voffB); PG8_STAGE(PG8_SA(0, 0), cA, voffA); PG8_STAGE(PG8_SA(0, 1), cA + hstepA, voffA);
    if (wr == 1) PG8_BAR;
    PG8_WAIT_V(2); PG8_BAR;
    PG8_STAGE(PG8_SB(1, 0), cB + kstep, voffB); PG8_STAGE(PG8_SA(1, 0), cA + kstep, voffA); PG8_STAGE(PG8_SB(1, 1), cB + hstepB + kstep, voffB);
    PG8_WAIT_V(6); PG8_BAR;
    for (;;) {
        const bool has_next = S.next(ui + 1, nxt);
        const char* nA = has_next ? (const char*)g.A + (size_t)nxt.pm * tstepA : cA; const char* nB = has_next ? (const char*)g.Bt + (size_t)nxt.pn * tstepB : cB;
        for (int t = 0; t < nt; t += 2) {
            const bool last = (t == nt - 2);
            const char* a1 = cA + (size_t)(t + 1) * kstep;
            const char* a2 = last ? nA : cA + (size_t)(t + 2) * kstep; const char* b2 = last ? nB : cB + (size_t)(t + 2) * kstep;
            const char* a3 = a2 + kstep; const char* b3 = b2 + kstep;
            PG8_LDB(B0, 0, 0); PG8_LDB(B1, 0, 1); PG8_SCHED; PG8_LDA(At, 0, 0); PG8_STAGE(PG8_SA(1, 1), a1 + hstepA, voffA);
            PG8_WAIT_V(8); PG8_WAIT_L(0); PG8_BAR; PG8_MMA(0, 0, At, B0); PG8_MMA(0, 1, At, B1); PG8_BAR; PG8_SCHED;
            PG8_LDA(At, 0, 1); PG8_STAGE(PG8_SB(0, 0), b2, voffB); PG8_STAGE(PG8_SB(0, 1), b2 + hstepB, voffB); PG8_STAGE(PG8_SA(0, 0), a2, voffA);
            PG8_WAIT_V(8); PG8_WAIT_L(0); PG8_BAR; PG8_MMA(1, 0, At, B0); PG8_MMA(1, 1, At, B1); PG8_BAR; PG8_SCHED;
            PG8_LDB(B0, 1, 0); PG8_LDB(B1, 1, 1); PG8_SCHED; PG8_LDA(At, 1, 0); PG8_STAGE(PG8_SA(0, 1), a2 + hstepA, voffA);
            PG8_WAIT_V(8); PG8_WAIT_L(0); PG8_BAR; PG8_MMA(0, 0, At, B0); PG8_MMA(0, 1, At, B1); PG8_BAR; PG8_SCHED;
            PG8_LDA(At, 1, 1); PG8_STAGE(PG8_SB(1, 0), b3, voffB); PG8_STAGE(PG8_SB(1, 1), b3 + hstepB, voffB); PG8_STAGE(PG8_SA(1, 0), a3, voffA);
            PG8_WAIT_V(8); PG8_WAIT_L(0); PG8_BAR; PG8_MMA(1, 0, At, B0); PG8_MMA(1, 1, At, B1); PG8_BAR; PG8_SCHED;
        }
        if constexpr (ALIGN_EPI) { if (wr == 0) PG8_BAR; }
        E(acc, cur, wr, wc, fr, fq);
        if (!has_next) break;
#pragma unroll
        for (int a = 0; a < 2; ++a)
#pragma unroll
            for (int b = 0; b < 2; ++b)
#pragma unroll
                for (int m = 0; m < 4; ++m)
#pragma unroll
                    for (int n = 0; n < 2; ++n) acc[a][b][m][n] = (f32x4){0.f, 0.f, 0.f, 0.f};
        cur = nxt; cA = nA; cB = nB; ++ui;
        if constexpr (ALIGN_EPI) { if (wr == 1) PG8_BAR; }
    }
    PG8_WAIT_V(0);
    if constexpr (!ALIGN_EPI) { if (wr == 0) PG8_BAR; }
    PG8_BAR;
#undef PG8_SA
#undef PG8_SB
#undef PG8_STAGE
#undef PG8_LDA
#undef PG8_LDB
#undef PG8_MMA
#undef PG8_WAIT_V
#undef PG8_WAIT_L
#undef PG8_BAR
#undef PG8_SCHED
}
}

typedef const f32x4 (&AccRef)[2][2][4][2];

struct EpiGU {
    static constexpr bool PERM = true;
    bf16_t* act;
    __device__ __forceinline__ void operator()(AccRef acc, const pg8::Unit& u, int wr, int wc, int fr, int fq) const {
        asm volatile("" : "+v"(fr), "+v"(fq));
        const int row0 = u.pm * 256 + wr * 64 + fr, col0 = u.pn * 128 + wc * 32 + 8 * fq;
#pragma unroll
        for (int ai = 0; ai < 2; ++ai)
#pragma unroll
            for (int m = 0; m < 4; ++m) {
                f32x4 r[2];
#pragma unroll
                for (int n = 0; n < 2; ++n) {
                    const f32x4 gt = acc[ai][0][m][n], up = acc[ai][1][m][n];
#pragma unroll
                    for (int j = 0; j < 4; ++j) r[n][j] = gt[j] * __builtin_amdgcn_rcpf(1.0f + __expf(-gt[j])) * up[j];
                }
                *(u32x4*)(act + (size_t)(row0 + ai * 128 + m * 16) * DFF + col0) = pack8(r[0], r[1]);
            }
    }
};
struct EpiD {
    static constexpr bool PERM = false;
    const float* X; float* Z; float cs;
    __device__ __forceinline__ void operator()(AccRef acc, const pg8::Unit& u, int wr, int wc, int fr, int fq) const {
        asm volatile("" : "+v"(fr), "+v"(fq));
        const int row0 = u.pm * 256 + wr * 64 + fr, col0 = u.pn * 256 + wc * 32 + 4 * fq;
#pragma unroll
        for (int ai = 0; ai < 2; ++ai)
#pragma unroll
            for (int m = 0; m < 4; ++m) {
                const size_t off = (size_t)(row0 + ai * 128 + m * 16) * DM + col0;
#pragma unroll
                for (int bj = 0; bj < 2; ++bj)
#pragma unroll
                    for (int n = 0; n < 2; ++n) { const size_t o = off + bj * 128 + n * 16; const f32x4 x = *(const f32x4*)(X + o); *(f32x4*)(Z + o) = x * ALPHA + acc[ai][bj][m][n] * cs; }
            }
    }
};
struct EpiBR {
    static constexpr bool PERM = false;
    const bf16_t* G; float* Z; bf16_t* MG; int mode;
    __device__ __forceinline__ void operator()(AccRef acc, const pg8::Unit& u, int wr, int wc, int fr, int fq) const {
        asm volatile("" : "+v"(fr), "+v"(fq));
        const int row0 = u.pm * 256 + wr * 64 + fr, col0 = u.pn * 256 + wc * 32 + 4 * fq;
#pragma unroll
        for (int ai = 0; ai < 2; ++ai)
#pragma unroll
            for (int m = 0; m < 4; ++m) {
                const int row = row0 + ai * 128 + m * 16;
#pragma unroll
                for (int bj = 0; bj < 2; ++bj)
#pragma unroll
                    for (int n = 0; n < 2; ++n) {
                        const int c = col0 + bj * 128 + n * 16;
                        const u32x2 gw = *(const u32x2*)(G + (size_t)row * 3072 + c);
                        f32x4 gt; gt[0] = __uint_as_float(gw.x << 16); gt[1] = __uint_as_float(gw.x & 0xffff0000u); gt[2] = __uint_as_float(gw.y << 16); gt[3] = __uint_as_float(gw.y & 0xffff0000u);
                        f32x4 v = gt * acc[ai][bj][m][n];
                        float* zp = Z + (size_t)row * DM + c;
                        if (mode != 0) v += *(const f32x4*)zp;
                        if (mode != 2) *(f32x4*)zp = v;
                        else { u32x2 w; w.x = pk2(v[0], v[1]); w.y = pk2(v[2], v[3]); *(u32x2*)(MG + (size_t)row * DM + c) = w; }
                    }
            }
    }
};
struct EpiMem {
    static constexpr bool PERM = false;
    float* out; bf16_t* MKV;
    __device__ __forceinline__ void operator()(AccRef acc, const pg8::Unit& u, int wr, int wc, int fr, int fq) const {
        asm volatile("" : "+v"(fr), "+v"(fq));
        const int l = u.pn >> 1, kv = u.pn & 1;
        float* ob = out + (kv ? O_PMV : O_PMK) + (size_t)l * 1024 * 256;
        bf16_t* bb = MKV + (size_t)(l * 2 + kv) * 1024 * 256;
        const int row0 = u.pm * 256 + wr * 64 + fr, col0 = wc * 32 + 4 * fq;
#pragma unroll
        for (int ai = 0; ai < 2; ++ai)
#pragma unroll
            for (int m = 0; m < 4; ++m) {
                const size_t off = (size_t)(row0 + ai * 128 + m * 16) * 256 + col0;
#pragma unroll
                for (int bj = 0; bj < 2; ++bj)
#pragma unroll
                    for (int n = 0; n < 2; ++n) { const size_t o = off + bj * 128 + n * 16; const f32x4 v = acc[ai][bj][m][n]; *(f32x4*)(ob + o) = v; u32x2 w; w.x = pk2(v[0], v[1]); w.y = pk2(v[2], v[3]); *(u32x2*)(bb + o) = w; }
            }
    }
};
struct EpiIN {
    static constexpr bool PERM = true;
    bf16_t *XP, *Q, *Kb, *Vb, *XQ, *G; float* out; const float* rope; int l;
    __device__ __forceinline__ void operator()(AccRef acc, const pg8::Unit& u, int wr, int wc, int fr, int fq) const {
        asm volatile("" : "+v"(fr), "+v"(fq));
        const int pn = u.pn;
        const int row0 = u.pm * 256 + wr * 64 + fr;
        const int cl = wc * 32 + 8 * fq;
        const bool ropelane = ((wc & 1) == 0) && (fq < 2);
#pragma unroll
        for (int ai = 0; ai < 2; ++ai)
#pragma unroll
            for (int m = 0; m < 4; ++m) {
                const int row = row0 + ai * 128 + m * 16;
                const bool smp = row >= NP;
                const int b = smp ? ((row - NP) >> 3) : (row >> 12);
                const int t = smp ? ((row - NP) & 7) : (row & 4095);
#pragma unroll
                for (int bj = 0; bj < 2; ++bj) {
                    f32x4 v0 = acc[ai][bj][m][0], v1 = acc[ai][bj][m][1];
                    const int c = cl + 128 * bj;
                    if (pn == 0) {
                        *(u32x4*)(XP + (size_t)row * 256 + c) = pack8(v0, v1);
                        if (smp) { float* o = out + O_SP + ((size_t)(l * DB + b) * 15 + 7 + t) * 256 + c; *(f32x4*)o = v0; *(f32x4*)(o + 4) = v1; }
                        else if (t >= SEQ - 15) { float* o = out + O_PP + ((size_t)(l * NB + b) * 15 + (t - (SEQ - 15))) * 256 + c; *(f32x4*)o = v0; *(f32x4*)(o + 4) = v1; }
                    } else if (pn <= 3) {
                        const bool isv = (pn == 3) && (bj == 1);
                        if (!isv) {
                            f32x4 p0, p1;
#pragma unroll
                            for (int j = 0; j < 4; ++j) { p0[j] = __shfl_xor(v0[j], 16); p1[j] = __shfl_xor(v1[j], 16); }
                            if (ropelane) {
                                const float* tp = rope + (size_t)(smp ? SEQ + t : t) * 16;
                                const f32x4 c0 = *(const f32x4*)tp, c1 = *(const f32x4*)(tp + 4), s0 = *(const f32x4*)(tp + 8), s1 = *(const f32x4*)(tp + 12);
                                const float sg = (fq == 0) ? -1.f : 1.f;
                                v0 = v0 * c0 + p0 * s0 * sg; v1 = v1 * c1 + p1 * s1 * sg;
                            }
                        }
                        if (pn < 3) { *(u32x4*)(Q + (size_t)row * 512 + (pn - 1) * 256 + c) = pack8(v0 * 0.125f, v1 * 0.125f); }
                        else {
                            bf16_t* dst = (bj == 0) ? Kb : Vb;
                            *(u32x4*)(dst + (size_t)row * 128 + cl) = pack8(v0, v1);
                            if (smp) { float* o = out + (bj == 0 ? O_SK : O_SV) + ((size_t)(l * DB + b) * 128 + 120 + t) * 128 + cl; *(f32x4*)o = v0; *(f32x4*)(o + 4) = v1; }
                            else if (t >= SEQ - 128) { float* o = out + (bj == 0 ? O_PK : O_PV) + ((size_t)(l * NB + b) * 128 + (t - (SEQ - 128))) * 128 + cl; *(f32x4*)o = v0; *(f32x4*)(o + 4) = v1; }
                        }
                    } else if (pn == 4) {
                        *(u32x4*)(XQ + (size_t)row * 256 + c) = pack8(v0 * 0.125f, v1 * 0.125f);
                    } else {
#pragma unroll
                        for (int j = 0; j < 4; ++j) { v0[j] = __builtin_amdgcn_rcpf(1.0f + __expf(-v0[j])); v1[j] = __builtin_amdgcn_rcpf(1.0f + __expf(-v1[j])); }
                        *(u32x4*)(G + (size_t)row * 3072 + (pn - 5) * 256 + c) = pack8(v0, v1);
                    }
                }
            }
    }
};

__device__ __forceinline__ void transpose_item(const float* W, int N, int k0, int n0, bf16_t* dst, int ldd, LAS float* scr, int lane) {
#pragma unroll 8
    for (int i = 0; i < 32; ++i) { const int kk = 2 * i + (lane >> 5); scr[kk * 33 + (lane & 31)] = W[(size_t)(k0 + kk) * N + n0 + (lane & 31)]; }
    LDS_WAIT();
    const int c = lane & 7;
#pragma unroll
    for (int j = 0; j < 4; ++j) { const int n = (lane >> 3) + 8 * j; const LAS float* s = scr + (8 * c) * 33 + n;
        u32x4 o; o.x = pk2(s[0 * 33], s[1 * 33]); o.y = pk2(s[2 * 33], s[3 * 33]); o.z = pk2(s[4 * 33], s[5 * 33]); o.w = pk2(s[6 * 33], s[7 * 33]);
        *(u32x4*)(dst + (size_t)n * ldd + 8 * c) = o; }
    LDS_WAIT();
}
struct Job { const float* src; bf16_t* dst; int K, N, ldd, mode; };
__device__ __forceinline__ Job get_job(KP pp, int l, int ty) {
    const Params __attribute__((address_space(4)))& p = *pp;
    unsigned char* wl = p.ws + WS_W + (size_t)l * WL_STRIDE;
    Job j; j.mode = 0;
    switch (ty) {
    case 0: j.src = p.in[10] + (size_t)l * DM * DFF; j.dst = (bf16_t*)(wl + WL_GU1); j.K = DM; j.N = DFF; j.ldd = DM; j.mode = 1; break;
    case 1: j.src = p.in[11] + (size_t)l * DM * DFF; j.dst = (bf16_t*)(wl + WL_GU1); j.K = DM; j.N = DFF; j.ldd = DM; j.mode = 2; break;
    case 2: j.src = p.in[12] + (size_t)l * DFF * DM; j.dst = (bf16_t*)(wl + WL_D1); j.K = DFF; j.N = DM; j.ldd = DFF; break;
    case 3: j.src = p.in[15] + (size_t)l * DM * INC; j.dst = (bf16_t*)(wl + WL_IN); j.K = DM; j.N = INC; j.ldd = DM; break;
    case 4: j.src = p.in[19] + (size_t)l * 256 * DM; j.dst = (bf16_t*)(wl + WL_BR); j.K = 256; j.N = DM; j.ldd = DM; break;
    case 5: j.src = p.in[20] + (size_t)l * 512 * DM; j.dst = (bf16_t*)(wl + WL_BR) + 256; j.K = 512; j.N = DM; j.ldd = DM; break;
    case 6: j.src = p.in[21] + (size_t)l * 256 * DM; j.dst = (bf16_t*)(wl + WL_BR) + 768; j.K = 256; j.N = DM; j.ldd = DM; break;
    case 7: j.src = p.in[22] + (size_t)l * DM * DM; j.dst = (bf16_t*)(wl + WL_O); j.K = DM; j.N = DM; j.ldd = DM; break;
    case 8: j.src = p.in[25] + (size_t)l * DM * DFF; j.dst = (bf16_t*)(wl + WL_GU2); j.K = DM; j.N = DFF; j.ldd = DM; j.mode = 1; break;
    case 9: j.src = p.in[26] + (size_t)l * DM * DFF; j.dst = (bf16_t*)(wl + WL_GU2); j.K = DM; j.N = DFF; j.ldd = DM; j.mode = 2; break;
    case 10: j.src = p.in[27] + (size_t)l * DFF * DM; j.dst = (bf16_t*)(wl + WL_D2); j.K = DFF; j.N = DM; j.ldd = DFF; break;
    case 11: j.src = p.in[8] + (size_t)l * DM * 256; j.dst = (bf16_t*)(p.ws + WS_WMEM) + (size_t)(l * 2 + 0) * 256 * DM; j.K = DM; j.N = 256; j.ldd = DM; break;
    default: j.src = p.in[9] + (size_t)l * DM * 256; j.dst = (bf16_t*)(p.ws + WS_WMEM) + (size_t)(l * 2 + 1) * 256 * DM; j.K = DM; j.N = 256; j.ldd = DM; break;
    }
    return j;
}
__device__ __forceinline__ void prologue_phase(KP pp, LAS unsigned char* lds) {
    const Params __attribute__((address_space(4)))& p = *pp;
    int tid = threadIdx.x; asm volatile("" : "+v"(tid));
    const int lane = tid & 63, wave = tid >> 6;
    const int gw = blockIdx.x * 8 + wave, NGW = gridDim.x * 8;
    LAS float* scr = (LAS float*)(lds + wave * 16384);
    int base = 0;
#pragma nounroll
    for (int l = 0; l < DEPTH; ++l) {
#pragma nounroll
        for (int ty = 0; ty < 13; ++ty) {
            const Job j = get_job(pp, l, ty);
            const int nblk = j.N >> 5, nit = (j.K >> 6) * nblk;
            int it0 = (gw - base) % NGW; if (it0 < 0) it0 += NGW;
            for (int it = it0; it < nit; it += NGW) {
                const int kb = it / nblk, nb = it - kb * nblk, k0 = kb * 64, n0 = nb * 32;
                int drow = n0;
                if (j.mode) drow = 256 * (n0 >> 7) + (n0 & 127) + (j.mode == 2 ? 128 : 0);
                transpose_item(j.src, j.N, k0, n0, j.dst + (size_t)drow * j.ldd + k0, j.ldd, scr, lane);
            }
            base = (base + nit) % NGW;
        }
    }
    const int gt = blockIdx.x * 512 + tid, NGT = gridDim.x * 512;
    float* rope = (float*)(p.ws + WS_ROPE);
    for (int e = gt; e < (SEQ + DSEQ) * 8; e += NGT) {
        const int idx = e >> 3, i = e & 7; const int pos = idx < SEQ ? idx : 8192 + (idx - SEQ);
        const float angf = (float)pos * p.invf[i];
        const double a = (double)angf; const double TWO_PI = 6.283185307179586476925286766559;
        const double kq = __builtin_rint(a / TWO_PI); const double r = a - kq * TWO_PI; const double r2 = r * r;
        double sn = r, cs = 1.0, ts = r, tc = 1.0;
#pragma unroll 1
        for (int n = 1; n <= 15; ++n) { tc = -tc * r2 / (double)((2 * n - 1) * (2 * n)); ts = -ts * r2 / (double)((2 * n) * (2 * n + 1)); cs += tc; sn += ts; }
        rope[(size_t)idx * 16 + i] = (float)cs; rope[(size_t)idx * 16 + 8 + i] = (float)sn;
    }
    { const float* mp = p.in[7]; bf16_t* mb = (bf16_t*)(p.ws + WS_MEMB);
      for (int e = gt; e < 1024 * 1024 / 8; e += NGT) { const f32x4 a = *(const f32x4*)(mp + (size_t)e * 8), b = *(const f32x4*)(mp + (size_t)e * 8 + 4); *(u32x4*)(mb + (size_t)e * 8) = pack8(a, b); } }
    { bf16_t* xb = (bf16_t*)(p.ws + WS_XB); float* X = p.out + O_Y;
      for (int e = gt; e < MROWS * DM / 8; e += NGT) {
          const size_t o = (size_t)e * 8; const float* src = o < (size_t)NP * DM ? p.in[0] + o : p.in[1] + (o - (size_t)NP * DM);
          const f32x4 a = *(const f32x4*)src, b = *(const f32x4*)(src + 4); *(f32x4*)(X + o) = a; *(f32x4*)(X + o + 4) = b; *(u32x4*)(xb + o) = pack8(a, b); } }
}

__device__ __forceinline__ void ln_phase(const float* Z, float* X, bf16_t* XB, const float* g, const float* b) {
    int tid = threadIdx.x; asm volatile("" : "+v"(tid));
    const int lane = tid & 63, wave = tid >> 6;
    const int gw = blockIdx.x * 8 + wave, NGW = gridDim.x * 8;
    f32x4 gg[4], bb[4];
#pragma unroll
    for (int j = 0; j < 4; ++j) { gg[j] = *(const f32x4*)(g + 256 * j + 4 * lane); bb[j] = *(const f32x4*)(b + 256 * j + 4 * lane); }
    for (int row = gw; row < MROWS; row += NGW) {
        const f32x4* zr = (const f32x4*)(Z + (size_t)row * DM) + lane;
        f32x4 v[4]; float s = 0.f;
#pragma unroll
        for (int j = 0; j < 4; ++j) { v[j] = zr[64 * j]; s += (v[j][0] + v[j][1]) + (v[j][2] + v[j][3]); }
        const float mean = wave_sum(s) * (1.f / DM); float s2 = 0.f;
#pragma unroll
        for (int j = 0; j < 4; ++j) { v[j] = v[j] - mean; s2 += (v[j][0] * v[j][0] + v[j][1] * v[j][1]) + (v[j][2] * v[j][2] + v[j][3] * v[j][3]); }
        const float rstd = 1.f / sqrtf(wave_sum(s2) * (1.f / DM) + LN_EPS);
        f32x4* xo = (f32x4*)(X + (size_t)row * DM) + lane; u32x2* bo = (u32x2*)(XB + (size_t)row * DM) + lane;
#pragma unroll
        for (int j = 0; j < 4; ++j) { const f32x4 o = v[j] * rstd * gg[j] + bb[j]; xo[64 * j] = o; u32x2 w; w.x = pk2(o[0], o[1]); w.y = pk2(o[2], o[3]); bo[64 * j] = w; }
    }
}

constexpr int KPITCH = 144;
constexpr int VPITCH = 520;
constexpr int LDS_KS = 0, LDS_VT = 256 * KPITCH;
__device__ __forceinline__ int crow(int i, int h) { return (i & 3) + 8 * (i >> 2) + 4 * h; }
__device__ __forceinline__ bf16x8 packrow(const f32x16& x, int s) {
    u32x4 w; w.x = pk2(x[8 * s + 0], x[8 * s + 1]); w.y = pk2(x[8 * s + 2], x[8 * s + 3]); w.z = pk2(x[8 * s + 4], x[8 * s + 5]); w.w = pk2(x[8 * s + 6], x[8 * s + 7]);
    return __builtin_bit_cast(bf16x8, w);
}
#define MFMA32(a, b, c) __builtin_amdgcn_mfma_f32_32x32x16_bf16((a), (b), (c), 0, 0, 0)
template <bool MASK>
__device__ __forceinline__ void attn_qtile(const LAS unsigned char* Ks, const LAS unsigned char* Vts, int c_lo, int c_hi, const bf16_t* qptr, int qi, float m_init, float l_init, bf16_t* optr, bool do_store, int lane) {
    const int r = lane & 31, h = lane >> 5;
    bf16x8 qf[4];
#pragma unroll
    for (int s = 0; s < 4; ++s) qf[s] = *(const bf16x8*)(qptr + 16 * s + 8 * h);
    f32x16 o0, o1;
#pragma unroll
    for (int i = 0; i < 16; ++i) { o0[i] = 0.f; o1[i] = 0.f; }
    float mrun = m_init, lrun = l_init;
#pragma nounroll
    for (int c = c_lo; c < c_hi; ++c) {
        const int kb = 64 * c;
        f32x16 s0, s1;
#pragma unroll
        for (int i = 0; i < 16; ++i) { s0[i] = 0.f; s1[i] = 0.f; }
#pragma unroll
        for (int s = 0; s < 4; ++s) {
            const bf16x8 k0 = *(const LAS bf16x8*)(Ks + (kb + r) * KPITCH + 32 * s + 16 * h);
            const bf16x8 k1 = *(const LAS bf16x8*)(Ks + (kb + 32 + r) * KPITCH + 32 * s + 16 * h);
            s0 = MFMA32(k0, qf[s], s0); s1 = MFMA32(k1, qf[s], s1);
        }
        if (MASK) {
#pragma unroll
            for (int i = 0; i < 16; ++i) { const int j0 = kb + crow(i, h), j1 = j0 + 32;
                if (!(j0 > qi && j0 <= qi + 128)) s0[i] = -INFINITY;
                if (!(j1 > qi && j1 <= qi + 128)) s1[i] = -INFINITY; }
        }
        float cm = fmaxf(s0[0], s1[0]);
#pragma unroll
        for (int i = 1; i < 16; ++i) cm = fmaxf(cm, fmaxf(s0[i], s1[i]));
        cm = fmaxf(cm, __shfl_xor(cm, 32));
        const float mn = fmaxf(mrun, cm);
        const float alpha = __expf(mrun - mn);
        mrun = mn;
        float ps = 0.f;
#pragma unroll
        for (int i = 0; i < 16; ++i) { s0[i] = __expf(s0[i] - mn); s1[i] = __expf(s1[i] - mn); ps += s0[i] + s1[i]; }
        lrun = lrun * alpha + ps;
#pragma unroll
        for (int i = 0; i < 16; ++i) { o0[i] *= alpha; o1[i] *= alpha; }
        const bf16x8 p00 = packrow(s0, 0), p01 = packrow(s0, 1), p10 = packrow(s1, 0), p11 = packrow(s1, 1);
#pragma unroll
        for (int dt = 0; dt < 2; ++dt) {
            const LAS unsigned char* vrow = Vts + (32 * dt + r) * VPITCH + (kb + 4 * h) * 2;
            f32x16 o = dt ? o1 : o0;
#pragma unroll
            for (int tt = 0; tt < 2; ++tt)
#pragma unroll
                for (int s2 = 0; s2 < 2; ++s2) {
                    const s16x4 lo = *(const LAS s16x4*)(vrow + (32 * tt + 16 * s2) * 2);
                    const s16x4 hi = *(const LAS s16x4*)(vrow + (32 * tt + 16 * s2 + 8) * 2);
                    const bf16x8 vf = __builtin_shufflevector(lo, hi, 0, 1, 2, 3, 4, 5, 6, 7);
                    const bf16x8 pf = tt ? (s2 ? p11 : p10) : (s2 ? p01 : p00);
                    o = MFMA32(vf, pf, o);
                }
            if (dt) o1 = o; else o0 = o;
        }
    }
    const float lt = lrun + __shfl_xor(lrun, 32);
    const float inv = 1.0f / lt;
    if (do_store) {
#pragma unroll
        for (int g4 = 0; g4 < 4; ++g4) {
            u32x2 w0, w1;
            w0.x = pk2(o0[4 * g4 + 0] * inv, o0[4 * g4 + 1] * inv); w0.y = pk2(o0[4 * g4 + 2] * inv, o0[4 * g4 + 3] * inv);
            w1.x = pk2(o1[4 * g4 + 0] * inv, o1[4 * g4 + 1] * inv); w1.y = pk2(o1[4 * g4 + 2] * inv, o1[4 * g4 + 3] * inv);
            *(u32x2*)(optr + 8 * g4 + 4 * h) = w0;
            *(u32x2*)(optr + 32 + 8 * g4 + 4 * h) = w1;
        }
    }
}
__device__ __forceinline__ u32x4 ld8_f32(const float* p) { const f32x4 a = *(const f32x4*)p, b = *(const f32x4*)(p + 4); return pack8(a, b); }
__device__ __forceinline__ void put_kv(LAS unsigned char* Ks, LAS unsigned char* Vts, int key, int ch, u32x4 kk, u32x4 vv) {
    *(LAS u32x4*)(Ks + key * KPITCH + ch * 16) = kk;
    LAS unsigned short* vp = (LAS unsigned short*)(Vts + (ch * 8) * VPITCH + key * 2);
    constexpr int VP2 = VPITCH / 2;
    vp[0 * VP2] = (unsigned short)(vv.x & 0xffffu); vp[1 * VP2] = (unsigned short)(vv.x >> 16);
    vp[2 * VP2] = (unsigned short)(vv.y & 0xffffu); vp[3 * VP2] = (unsigned short)(vv.y >> 16);
    vp[4 * VP2] = (unsigned short)(vv.z & 0xffffu); vp[5 * VP2] = (unsigned short)(vv.z >> 16);
    vp[6 * VP2] = (unsigned short)(vv.w & 0xffffu); vp[7 * VP2] = (unsigned short)(vv.w >> 16);
}

template <int W>
__device__ __forceinline__ void pool_rows(const float (&v)[23], bool prompt, int t0, LAS float* dsm, int rbase, int col) {
#pragma unroll
    for (int i = 0; i < 8; ++i) {
        float s = 0.f;
#pragma unroll
        for (int k = 0; k < W; ++k) s += v[15 + i - k];
        const int cnt = prompt ? ((t0 + i + 1) < W ? (t0 + i + 1) : W) : W;
        dsm[(rbase + i) * 256 + col] = s / (float)cnt - v[15 + i];
    }
}
__device__ __forceinline__ void mix_phase(KP pp, int l, LAS unsigned char* lds) {
    const Params __attribute__((address_space(4)))& p = *pp;
    int tid = threadIdx.x; asm volatile("" : "+v"(tid));
    const int lane = tid & 63, wave = __builtin_amdgcn_readfirstlane(tid >> 6);
    const bf16_t* XP = (const bf16_t*)(p.ws + WS_XP); const bf16_t* Q = (const bf16_t*)(p.ws + WS_Q);
    const bf16_t* Kb = (const bf16_t*)(p.ws + WS_K); const bf16_t* Vb = (const bf16_t*)(p.ws + WS_V);
    const bf16_t* XQ = (const bf16_t*)(p.ws + WS_XQ); bf16_t* Y = (bf16_t*)(p.ws + WS_YB);
    LAS unsigned char* Ks = lds + LDS_KS; LAS unsigned char* Vts = lds + LDS_VT;
    const float* sink = p.in[18] + l * 8;
    const int r = lane & 31;
    constexpr int NU = 256 + 256 + 256 + 512 + 544;
    for (int u = blockIdx.x; u < NU; u += gridDim.x) {
        __syncthreads();
        if (u < 256) {
            const int kvh = u & 1, blk = (u >> 1) & 31, b = u >> 6;
            const int jlo = blk == 0 ? 128 : 0;
            const size_t krow0 = (size_t)b * SEQ + (blk - 1) * 128;
            for (int it = tid + jlo * 8; it < 256 * 8; it += 512) { const int key = it >> 3, ch = it & 7;
                const size_t o = (krow0 + key) * 128 + kvh * 64 + ch * 8;
                put_kv(Ks, Vts, key, ch, *(const u32x4*)(Kb + o), *(const u32x4*)(Vb + o)); }
            __syncthreads();
#pragma nounroll
            for (int q2 = 0; q2 < 2; ++q2) {
                const int qt = wave * 2 + q2, g = qt >> 2, i0 = (qt & 3) * 32;
                int c_lo = i0 >= 64 ? 1 : 0, c_hi = i0 >= 64 ? 4 : 3; if (blk == 0) c_lo = 2;
                const size_t row = (size_t)b * SEQ + blk * 128 + i0 + r;
                const int hq = kvh * 4 + g;
                attn_qtile<true>(Ks, Vts, c_lo, c_hi, Q + row * 512 + hq * 64, i0 + r, sink[hq], (lane < 32) ? 1.f : 0.f, Y + row * 1024 + 256 + hq * 64, true, lane);
            }
        } else if (u < 512) {
            const int v = u - 256, head = v & 3, qb = (v >> 2) & 15, b = v >> 6;
            const bf16_t* mk = (const bf16_t*)(p.ws + WS_MEMKV) + (size_t)(l * 2 + 0) * 1024 * 256 + (size_t)b * 256 * 256 + head * 64;
            const bf16_t* mv = (const bf16_t*)(p.ws + WS_MEMKV) + (size_t)(l * 2 + 1) * 1024 * 256 + (size_t)b * 256 * 256 + head * 64;
            for (int it = tid; it < 256 * 8; it += 512) { const int key = it >> 3, ch = it & 7; const size_t o = (size_t)key * 256 + ch * 8;
                put_kv(Ks, Vts, key, ch, *(const u32x4*)(mk + o), *(const u32x4*)(mv + o)); }
            __syncthreads();
            const size_t row = (size_t)b * SEQ + qb * 256 + wave * 32 + r;
            attn_qtile<false>(Ks, Vts, 0, 4, XQ + row * 256 + head * 64, 0, -INFINITY, 0.f, Y + row * 1024 + 768 + head * 64, true, lane);
        } else if (u < 768) {
            const int v = u - 512, kvh = v & 1, b = v >> 1;
            const float* ck = p.in[2] + ((size_t)(l * DB + b) * 128) * 128 + kvh * 64;
            const float* cv = p.in[3] + ((size_t)(l * DB + b) * 128) * 128 + kvh * 64;
            float* ok = p.out + O_SK + ((size_t)(l * DB + b) * 128) * 128 + kvh * 64;
            float* ov = p.out + O_SV + ((size_t)(l * DB + b) * 128) * 128 + kvh * 64;
            for (int it = tid; it < 192 * 8; it += 512) { const int key = it >> 3, ch = it & 7;
                u32x4 kk = (u32x4){0u, 0u, 0u, 0u}, vv = (u32x4){0u, 0u, 0u, 0u};
                if (key < 128) {
                    const size_t o = (size_t)key * 128 + ch * 8;
                    const f32x4 ka = *(const f32x4*)(ck + o), kb2 = *(const f32x4*)(ck + o + 4), va = *(const f32x4*)(cv + o), vb2 = *(const f32x4*)(cv + o + 4);
                    kk = pack8(ka, kb2); vv = pack8(va, vb2);
                    if (key >= 8) { const size_t oo = (size_t)(key - 8) * 128 + ch * 8; *(f32x4*)(ok + oo) = ka; *(f32x4*)(ok + oo + 4) = kb2; *(f32x4*)(ov + oo) = va; *(f32x4*)(ov + oo + 4) = vb2; }
                } else if (key < 136) {
                    const size_t o = ((size_t)NP + b * 8 + (key - 128)) * 128 + kvh * 64 + ch * 8;
                    kk = *(const u32x4*)(Kb + o); vv = *(const u32x4*)(Vb + o);
                }
                put_kv(Ks, Vts, key, ch, kk, vv); }
            __syncthreads();
            if (wave == 0) {
                const int g = r >> 3, t = r & 7, hq = kvh * 4 + g;
                const size_t row = (size_t)NP + b * 8 + t;
                attn_qtile<true>(Ks, Vts, 0, 3, Q + row * 512 + hq * 64, t, sink[hq], (lane < 32) ? 1.f : 0.f, Y + row * 1024 + 256 + hq * 64, true, lane);
            }
        } else if (u < 1280) {
            const int v = u - 768, head = v & 3, b = v >> 2;
            const float* mk = p.in[5] + ((size_t)(l * DB + b) * 256) * 256 + head * 64;
            const float* mv = p.in[6] + ((size_t)(l * DB + b) * 256) * 256 + head * 64;
            for (int it = tid; it < 256 * 8; it += 512) { const int key = it >> 3, ch = it & 7; const size_t o = (size_t)key * 256 + ch * 8;
                put_kv(Ks, Vts, key, ch, ld8_f32(mk + o), ld8_f32(mv + o)); }
            __syncthreads();
            if (wave == 0) {
                const size_t row = (size_t)NP + b * 8 + (r & 7);
                attn_qtile<false>(Ks, Vts, 0, 4, XQ + row * 256 + head * 64, 0, -INFINITY, 0.f, Y + row * 1024 + 768 + head * 64, r < 8, lane);
            }
        } else {
            const int pc = u - 1280;
            LAS float* dsm = (LAS float*)lds;
            const int col = tid & 255, sub = tid >> 8, grp = col >> 6;
#pragma nounroll
            for (int gi = 0; gi < 2; ++gi) {
                const int g8 = sub * 2 + gi; const int R0 = pc * 32 + g8 * 8;
                float v[23]; bool prompt = R0 < NP; int t0 = 0;
                if (prompt) {
                    t0 = R0 & (SEQ - 1);
#pragma unroll
                    for (int k = 0; k < 23; ++k) v[k] = (t0 - 15 + k >= 0) ? bf2f(XP[(size_t)(R0 - 15 + k) * 256 + col]) : 0.f;
                } else {
                    const int sb = (R0 - NP) >> 3;
                    const float* sp = p.in[4] + ((size_t)(l * DB + sb) * 15) * 256 + col;
#pragma unroll
                    for (int k = 0; k < 15; ++k) v[k] = sp[(size_t)k * 256];
#pragma unroll
                    for (int k = 0; k < 8; ++k) v[15 + k] = bf2f(XP[(size_t)(R0 + k) * 256 + col]);
                    float* op = p.out + O_SP + ((size_t)(l * DB + sb) * 15) * 256 + col;
#pragma unroll
                    for (int k = 0; k < 7; ++k) op[(size_t)k * 256] = v[8 + k];
                }
                if (grp == 0) pool_rows<2>(v, prompt, t0, dsm, g8 * 8, col);
                else if (grp == 1) pool_rows<4>(v, prompt, t0, dsm, g8 * 8, col);
                else if (grp == 2) pool_rows<8>(v, prompt, t0, dsm, g8 * 8, col);
                else pool_rows<16>(v, prompt, t0, dsm, g8 * 8, col);
            }
            __syncthreads();
            const float* pm = p.in[16] + ((size_t)(l * 4 + grp) * 64) * 64 + (col & 63);
            float wreg[64];
#pragma unroll
            for (int c = 0; c < 64; ++c) wreg[c] = pm[c * 64];
            const float psc = p.in[17][l * 256 + col];
#pragma nounroll
            for (int rr = 0; rr < 16; ++rr) {
                const int row = sub * 16 + rr;
                const LAS f32x4* dp = (const LAS f32x4*)(dsm + row * 256 + grp * 64);
                float a = 0.f;
#pragma unroll
                for (int c4 = 0; c4 < 16; ++c4) { const f32x4 d = dp[c4]; a += d[0] * wreg[4 * c4] + d[1] * wreg[4 * c4 + 1] + d[2] * wreg[4 * c4 + 2] + d[3] * wreg[4 * c4 + 3]; }
                const unsigned w = pk2(a * psc, 0.f);
                Y[(size_t)(pc * 32 + row) * 1024 + col] = (bf16_t)(w & 0xffffu);
            }
        }
    }
}


#define XB_TMO      128
#define XB_XCNT(j)  (256  + 64 * (j))
#define XB_XSUB(j)  (1280 + 64 * (j))
#define XB_XGEN(j)  (2304 + 64 * (j))
#define XB_TOP      3328
#define XB_TOPGEN   3392
#define XCD_BAR_WORDS 3456
#define XB_SPIN_CAP (1u << 18)
__device__ __forceinline__ unsigned xb_ld(unsigned* p)              { return __hip_atomic_load(p, __ATOMIC_RELAXED, __HIP_MEMORY_SCOPE_AGENT); }
__device__ __forceinline__ unsigned xb_add(unsigned* p, unsigned v) { return __hip_atomic_fetch_add(p, v, __ATOMIC_RELAXED, __HIP_MEMORY_SCOPE_AGENT); }
__device__ __forceinline__ unsigned xb_xcc_id() { return (unsigned)__builtin_amdgcn_s_getreg((3 << 11) | 20) & 0xFu; }
#define XB_SPIN(cond, bar) do { unsigned _sp = 0; while (cond) { __builtin_amdgcn_s_sleep(1); \
    if ((++_sp & 255u) == 0u) { if (xb_ld(&(bar)[XB_TMO])) break; if (_sp > XB_SPIN_CAP) { atomicAdd(&(bar)[XB_TMO], 1u); break; } } } } while (0)
struct XcdBarrier { unsigned* bar; unsigned x; volatile LAS unsigned* st; };
__device__ __forceinline__ XcdBarrier xcd_barrier_post(unsigned* bar, volatile LAS unsigned* st) {
    XcdBarrier b; b.bar = bar; b.x = xb_xcc_id(); b.st = st;
    if (threadIdx.x == 0) (void)xb_add(&bar[XB_XCNT(b.x)], 1u);
    return b;
}
__device__ __forceinline__ void xcd_barrier_complete(unsigned* bar, unsigned x, unsigned& nloc, unsigned& nx) {
    const unsigned G = gridDim.x * gridDim.y * gridDim.z;
    unsigned sum, cnt, mine, sp = 0u;
    for (;;) {
        sum = 0u; cnt = 0u; mine = 0u;
#pragma unroll
        for (unsigned j = 0; j < 16; ++j) { const unsigned c = xb_ld(&bar[XB_XCNT(j)]); sum += c; cnt += (c > 0u) ? 1u : 0u; mine = (j == x) ? c : mine; }
        if (sum == G) break;
        __builtin_amdgcn_s_sleep(1);
        if ((++sp & 255u) == 0u) { if (xb_ld(&bar[XB_TMO])) break; if (sp > XB_SPIN_CAP) { atomicAdd(&bar[XB_TMO], 1u); break; } }
    }
    nloc = mine > 0u ? mine : 1u; nx = cnt > 0u ? cnt : 1u;
}
__device__ __forceinline__ void xcd_barrier(const XcdBarrier& b) {
    asm volatile("s_waitcnt vmcnt(0)" ::: "memory");
    __syncthreads();
    if (threadIdx.x == 0) {
        unsigned* bar = b.bar;
        __builtin_amdgcn_s_waitcnt(0);
        unsigned nloc = b.st[0], nx = b.st[1];
        if (nloc == 0u) { xcd_barrier_complete(bar, b.x, nloc, nx); b.st[0] = nloc; b.st[1] = nx; }
        const unsigned old = xb_add(&bar[XB_XSUB(b.x)], 1u);
        const unsigned gen = old / nloc;
        if (old + 1u == (gen + 1u) * nloc) {
            __builtin_amdgcn_fence(__ATOMIC_RELEASE, "agent");
            asm volatile("s_waitcnt vmcnt(0)" ::: "memory");
            const unsigned og = xb_add(&bar[XB_TOP], 1u);
            const unsigned tg = og / nx;
            if (og + 1u == (tg + 1u) * nx) xb_add(&bar[XB_TOPGEN], 1u);
            else XB_SPIN(xb_ld(&bar[XB_TOPGEN]) == tg, bar);
            __builtin_amdgcn_fence(__ATOMIC_ACQUIRE, "agent");
            xb_add(&bar[XB_XGEN(b.x)], 1u);
            asm volatile("s_waitcnt vmcnt(0)" ::: "memory");
        } else {
            XB_SPIN(xb_ld(&bar[XB_XGEN(b.x)]) == gen, bar);
            __builtin_amdgcn_fence(__ATOMIC_ACQUIRE, "agent");
            asm volatile("s_waitcnt vmcnt(0)" ::: "memory");
        }
    }
    __syncthreads();
}
constexpr int MISC_OFF = 131072 + 320;
constexpr size_t CTL_ZERO_BYTES = 16384;

__global__ void __launch_bounds__(512, 2) fwd_kernel(Params p_unused) {
    extern __shared__ __attribute__((aligned(16))) unsigned char lds_raw[];
    LAS unsigned char* lds = (LAS unsigned char*)lds_raw;
    const int G = gridDim.x, bx = blockIdx.x;
    if (threadIdx.x < 32) ((LAS unsigned*)(lds + MISC_OFF))[threadIdx.x] = 0u;
    __syncthreads();
    unsigned* barw; { KP pp0 = (KP)__builtin_amdgcn_kernarg_segment_ptr(); barw = (unsigned*)pp0->ws; }
    const XcdBarrier bar = xcd_barrier_post(barw, (volatile LAS unsigned*)(lds + MISC_OFF) + 8);
    int ph_lo, ph_hi;
    { KP pp0 = (KP)__builtin_amdgcn_kernarg_segment_ptr(); ph_lo = pp0->ph_lo; ph_hi = pp0->ph_hi; }
#pragma nounroll
    for (int ph = ph_lo; ph < ph_hi; ++ph) {
        if (ph > ph_lo) { if (ph == ph_lo + 1) cg::this_grid().sync(); else xcd_barrier(bar); }
        KP pp = (KP)__builtin_amdgcn_kernarg_segment_ptr(); asm volatile("" : "+s"(pp));
        const Params __attribute__((address_space(4)))& p = *pp;
        if (ph == 0) { prologue_phase(pp, lds); continue; }
        float* X = p.out + O_Y;
        bf16_t* XB = (bf16_t*)(p.ws + WS_XB); float* Z = (float*)(p.ws + WS_Z);
        bf16_t* ACT = (bf16_t*)(p.ws + WS_ACT);
        const int l = (ph - 1) / 11, sp = (ph - 1) % 11;
#pragma nounroll
        for (int rep = 0; rep < (((REP_MASK >> sp) & 1) ? 2 : 1); ++rep) {
        unsigned char* wl = p.ws + WS_W + (size_t)l * WL_STRIDE;
        if (sp == 0 || sp == 8) {
            pg8::Gemm g{XB, (const bf16_t*)(wl + (sp == 0 ? WL_GU1 : WL_GU2)), MROWS, 2 * DFF, DM, DM, DM};
            pg8::StaticOrder S; S.init(MROWS, 2 * DFF, G, bx);
            EpiGU E{ACT};
            pg8::gemm_phase<EpiGU, true>(lds, g, S, E);
            if (ph == 1 && bx >= G - 32) {
                pg8::Gemm g2{(const bf16_t*)(p.ws + WS_MEMB), (const bf16_t*)(p.ws + WS_WMEM), 1024, 2048, DM, DM, DM};
                pg8::StaticOrder S2; S2.init(1024, 2048, 32, bx - (G - 32));
                EpiMem E2{p.out, (bf16_t*)(p.ws + WS_MEMKV)};
                pg8::gemm_phase<EpiMem, true>(lds, g2, S2, E2);
            }
        } else if (sp == 1 || sp == 9 || sp == 6) {
            pg8::Gemm g;
            if (sp == 6) g = pg8::Gemm{(const bf16_t*)(p.ws + WS_MG), (const bf16_t*)(wl + WL_O), MROWS, DM, DM, DM, DM};
            else g = pg8::Gemm{ACT, (const bf16_t*)(wl + (sp == 1 ? WL_D1 : WL_D2)), MROWS, DM, DFF, DFF, DFF};
            pg8::StaticOrder S; S.init(MROWS, DM, G, bx);
            EpiD E{X, Z, sp == 6 ? 1.0f : 0.5f};
            pg8::gemm_phase<EpiD, true>(lds, g, S, E);
        } else if (sp == 2 || sp == 7 || sp == 10) {
            const int gi = sp == 2 ? 13 : (sp == 7 ? 23 : 28);
            ln_phase(Z, X, XB, p.in[gi] + l * DM, p.in[gi + 1] + l * DM);
        } else if (sp == 3) {
            pg8::Gemm g{XB, (const bf16_t*)(wl + WL_IN), MROWS, INC, DM, DM, DM};
            pg8::StaticOrder S; S.init(MROWS, INC, G, bx);
            EpiIN E{(bf16_t*)(p.ws + WS_XP), (bf16_t*)(p.ws + WS_Q), (bf16_t*)(p.ws + WS_K), (bf16_t*)(p.ws + WS_V), (bf16_t*)(p.ws + WS_XQ), (bf16_t*)(p.ws + WS_G), p.out, (const float*)(p.ws + WS_ROPE), l};
            pg8::gemm_phase<EpiIN, true>(lds, g, S, E);
        } else if (sp == 4) {
            mix_phase(pp, l, lds);
        } else {
#pragma nounroll
            for (int b = 0; b < 3; ++b) {
                const int koff = b == 0 ? 0 : (b == 1 ? 256 : 768), kk = b == 1 ? 512 : 256;
                pg8::Gemm g{(const bf16_t*)(p.ws + WS_YB) + koff, (const bf16_t*)(wl + WL_BR) + koff, MROWS, DM, kk, DM, DM};
                pg8::StaticOrder S; S.init(MROWS, DM, G, bx);
                EpiBR E{(const bf16_t*)(p.ws + WS_G) + b * 1024, Z, (bf16_t*)(p.ws + WS_MG), b};
                pg8::gemm_phase<EpiBR, true>(lds, g, S, E);
            }
        }
        }
    }
}

extern "C" void kernel_launch(void* const* d_in, const int* in_sizes, int n_in, void* d_out, int out_size, void* d_ws, size_t ws_size, hipStream_t stream) {
    static int grid = 0;
    if (grid == 0) {
        if (n_in != 30 || (size_t)out_size != O_END || ws_size < WS_END) { fprintf(stderr, "kernel_launch: unexpected shapes: n_in %d out %d ws %zu (need %zu)\n", n_in, out_size, ws_size, (size_t)WS_END); grid = -1; return; }
        int dev = 0, cus = 0, per_cu = 0;
        hipGetDevice(&dev); hipDeviceGetAttribute(&cus, hipDeviceAttributeMultiprocessorCount, dev);
        if (hipFuncSetAttribute((const void*)fwd_kernel, hipFuncAttributeMaxDynamicSharedMemorySize, LDS_BYTES) != hipSuccess) { fprintf(stderr, "kernel_launch: hipFuncSetAttribute failed\n"); grid = -1; return; }
        hipOccupancyMaxActiveBlocksPerMultiprocessor(&per_cu, (const void*)fwd_kernel, 512, LDS_BYTES);
        (void)hipGetLastError();
        if (per_cu < 1) { fprintf(stderr, "kernel_launch: occupancy query says %d blocks per CU\n", per_cu); per_cu = 1; }
        grid = cus;
    }
    if (grid < 0) return;
    if (hipMemsetAsync(d_ws, 0, CTL_ZERO_BYTES, stream) != hipSuccess) { fprintf(stderr, "kernel_launch: memset failed\n"); return; }
    Params p{};
    for (int i = 0; i < 30; ++i) p.in[i] = (const float*)d_in[i];
    p.out = (float*)d_out; p.ws = (unsigned char*)d_ws;
    for (int i = 0; i < 8; ++i) p.invf[i] = powf(500000.0f, -(float)i * 0.125f);
#if MK_MULTI
    for (int ph = 0; ph < NPHASE; ++ph) { p.ph_lo = ph; p.ph_hi = ph + 1; hipLaunchKernelGGL(fwd_kernel, dim3(grid), dim3(512), LDS_BYTES, stream, p); }
#else
    p.ph_lo = 0; p.ph_hi = NPHASE;
    void* args[] = {&p};
    hipError_t e = hipLaunchCooperativeKernel((const void*)fwd_kernel, dim3(grid), dim3(512), args, LDS_BYTES, stream);
    if (e != hipSuccess) fprintf(stderr, "kernel_launch: cooperative launch failed: %s (grid %d)\n", hipGetErrorString(e), grid);
#endif
}
```

```cpp
#include <hip/hip_runtime.h>
#include <hip/hip_cooperative_groups.h>
#include <cstdio>
#include <cstdint>
#include <cmath>
namespace cg = cooperative_groups;

#ifndef MK_MULTI
#define MK_MULTI 0
#endif

#ifndef REP_MASK
#define REP_MASK 0
#endif
#define LAS __attribute__((address_space(3)))
typedef unsigned short bf16_t;
typedef short bf16x8 __attribute__((ext_vector_type(8)));
typedef short s16x4 __attribute__((ext_vector_type(4)));
typedef float f32x2 __attribute__((ext_vector_type(2)));
typedef float f32x4 __attribute__((ext_vector_type(4)));
typedef float f32x16 __attribute__((ext_vector_type(16)));
typedef unsigned u32x2 __attribute__((ext_vector_type(2)));
typedef unsigned u32x4 __attribute__((ext_vector_type(4)));
typedef __bf16 bf16x2_t __attribute__((ext_vector_type(2)));

constexpr int DM = 1024, NP = 16384, NSMP = 1024, MROWS = NP + NSMP, DEPTH = 4, DFF = 2816, INC = 4352;
constexpr int SEQ = 4096, NB = 4, DB = 128, DSEQ = 8;
constexpr float ALPHA = 1.6817928305074290f;
constexpr float LN_EPS = 1e-5f;
constexpr size_t O_Y = 0;
constexpr size_t O_PK = (size_t)MROWS * DM;
constexpr size_t O_PV = O_PK + (size_t)DEPTH * NB * 128 * 128;
constexpr size_t O_PP = O_PV + (size_t)DEPTH * NB * 128 * 128;
constexpr size_t O_PMK = O_PP + (size_t)DEPTH * NB * 15 * 256;
constexpr size_t O_PMV = O_PMK + (size_t)DEPTH * NB * 256 * 256;
constexpr size_t O_SK = O_PMV + (size_t)DEPTH * NB * 256 * 256;
constexpr size_t O_SV = O_SK + (size_t)DEPTH * DB * 128 * 128;
constexpr size_t O_SP = O_SV + (size_t)DEPTH * DB * 128 * 128;
constexpr size_t O_END = O_SP + (size_t)DEPTH * DB * 15 * 256;

constexpr size_t MiB = 1u << 20;
constexpr size_t WS_ROPE = 1 * MiB;
constexpr size_t WS_W = 2 * MiB;
constexpr size_t WL_GU1 = 0, WL_D1 = 11 * MiB, WL_IN = WL_D1 + 11 * MiB / 2, WL_BR = WL_IN + 17 * MiB / 2, WL_O = WL_BR + 2 * MiB,
                 WL_GU2 = WL_O + 2 * MiB, WL_D2 = WL_GU2 + 11 * MiB, WL_STRIDE = WL_D2 + 11 * MiB / 2;
constexpr size_t WS_WMEM = WS_W + 4 * WL_STRIDE;
constexpr size_t WS_MEMB = WS_WMEM + 4 * MiB;
constexpr size_t WS_MEMKV = WS_MEMB + 2 * MiB;
constexpr size_t WS_XB = WS_MEMKV + 4 * MiB;
constexpr size_t WS_Z = WS_XB + 34 * MiB;
constexpr size_t WS_R = WS_Z + 68 * MiB;
constexpr size_t WS_ACT = WS_R;
constexpr size_t WS_XP = WS_R;
constexpr size_t WS_Q = WS_XP + (size_t)MROWS * 256 * 2;
constexpr size_t WS_K = WS_Q + (size_t)MROWS * 512 * 2;
constexpr size_t WS_V = WS_K + (size_t)MROWS * 128 * 2;
constexpr size_t WS_XQ = WS_V + (size_t)MROWS * 128 * 2;
constexpr size_t WS_G = WS_XQ + (size_t)MROWS * 256 * 2;
constexpr size_t WS_YB = WS_G + (size_t)MROWS * 3072 * 2;
constexpr size_t WS_MG = WS_YB + (size_t)MROWS * 1024 * 2;
constexpr size_t WS_END = WS_MG + (size_t)MROWS * 1024 * 2;
constexpr size_t WS_PART_D = WS_R + 100 * MiB;
constexpr size_t WS_PART_O = WS_R;
static_assert(WS_ACT + (size_t)MROWS * DFF * 2 <= WS_PART_D && WS_PART_D + 11 * 4 * MiB <= WS_END && WS_PART_O + 16 * MiB <= WS_G, "overlay");
static_assert(WS_END <= 512 * MiB, "workspace");

constexpr int LDS_BYTES = 147456;
constexpr int NPHASE = 1 + 11 * DEPTH;

struct Params { const float* in[30]; float* out; unsigned char* ws; float invf[8]; int ph_lo, ph_hi; };
typedef const Params __attribute__((address_space(4)))* KP;

__device__ __forceinline__ unsigned pk2(float lo, float hi) { f32x2 v = {lo, hi}; bf16x2_t b = __builtin_convertvector(v, bf16x2_t); return __builtin_bit_cast(unsigned, b); }
__device__ __forceinline__ float bf2f(unsigned short b) { return __uint_as_float(((unsigned)b) << 16); }
__device__ __forceinline__ u32x4 pack8(f32x4 a, f32x4 b) { u32x4 w; w.x = pk2(a[0], a[1]); w.y = pk2(a[2], a[3]); w.z = pk2(b[0], b[1]); w.w = pk2(b[2], b[3]); return w; }
__device__ __forceinline__ float wave_sum(float v) {
#pragma unroll
    for (int o = 1; o < 64; o <<= 1) v += __shfl_xor(v, o);
    return v;
}
#define LDS_WAIT() asm volatile("s_waitcnt lgkmcnt(0)" ::: "memory")

namespace pg8 {
constexpr int BM = 256, BK = 64, HALF = 128, HTB = HALF * BK * 2, STAGE_BYTES = 8 * HTB, NXCD = 8, WGM = 8;
__host__ __device__ __forceinline__ int lds_byte(int r, int c) { const int st = (r >> 4) * 2 + (c >> 5), rr = r & 15, cc = c & 31, ob = rr * 64 + cc * 2; return st * 1024 + (ob ^ (((ob >> 9) & 1) << 5)); }
__host__ __device__ __forceinline__ void stage_rc(int b, int& R, int& C) { const int st = b / 1024, sb = b % 1024, swz = sb ^ (((sb >> 9) & 1) << 5); R = (st >> 1) * 16 + swz / 64; C = (st & 1) * 32 + (swz % 64) / 2; }
__host__ __device__ __forceinline__ int perm32(int rho) { const int n = rho >> 4, i = rho & 15; return 8 * (i >> 2) + 4 * n + (i & 3); }

struct Unit { int pm, pn; };
struct Gemm { const bf16_t* A; const bf16_t* Bt; int M, N, K, lda, ldb; };

struct StaticOrder {
    int nM, nN, nwg, G, c;
    __device__ void init(int M, int N, int G_, int c_) { nM = M / BM; nN = N / BM; nwg = nM * nN; G = G_; c = c_; }
    __device__ bool next(int i, Unit& u) const {
        const long L = (long)i * G + c; if (L >= nwg) return false;
        int wgid = (int)L; { const int q = nwg / NXCD, r = nwg % NXCD, xcd = wgid % NXCD, off = wgid / NXCD; wgid = (xcd < r ? xcd * (q + 1) : r * (q + 1) + (xcd - r) * q) + off; }
        const int nig = WGM * nN, gid = wgid / nig, fm = gid * WGM, gsz = (nM - fm) < WGM ? (nM - fm) : WGM;
        u.pm = fm + ((wgid % nig) % gsz); u.pn = (wgid % nig) / gsz; return true;
    }
};

struct SingleOrder {
    Unit u;
    __device__ bool next(int i, Unit& o) const { if (i) return false; o = u; return true; }
};
template <class Epi, class Sched, bool ALIGN_EPI>
__device__ __forceinline__ void gemm_phase(LAS unsigned char* lds, const Gemm g, const Sched& S, const Epi& E, f32x4 (&acc)[2][2][4][2], bool keep) {
    int tid = threadIdx.x; asm volatile("" : "+v"(tid));
    const int wid = __builtin_amdgcn_readfirstlane(tid >> 6), lane = tid & 63, wr = wid >> 2, wc = wid & 3, fr = lane & 15, fq = lane >> 4;
    const int K = g.K, nt = K / BK;
    unsigned voffA[2], voffB[2];
#pragma unroll
    for (int i = 0; i < 2; ++i) { int R, C; stage_rc(tid * 16 + i * 8192, R, C); const int Rb = Epi::PERM ? ((R & ~31) + perm32(R & 31)) : R;
        voffA[i] = (unsigned)(R * g.lda + C) * 2u; voffB[i] = (unsigned)(Rb * g.ldb + C) * 2u; }
    const size_t kstep = (size_t)(BK * 2);
    const size_t hstepA = (size_t)HALF * g.lda * 2, hstepB = (size_t)HALF * g.ldb * 2;
    const size_t tstepA = 2 * hstepA, tstepB = 2 * hstepB;
    const unsigned ldsw = (unsigned)wid * 1024u;
    const int aoff = lds_byte(wr * 64 + fr, fq * 8), boff = lds_byte(wc * 32 + fr, fq * 8);
#define PG8_SA(b, h) (((b) * 2 + (h)) * HTB)
#define PG8_SB(b, h) ((4 + (b) * 2 + (h)) * HTB)
#define PG8_STAGE(bufoff, gbase, voff) do { _Pragma("unroll") for (int _i = 0; _i < 2; ++_i) \
        __builtin_amdgcn_global_load_lds((const unsigned*)((const char*)(gbase) + (voff)[_i]), (LAS unsigned*)(lds + (bufoff) + ldsw + _i * 8192), 16, 0, 0); } while (0)
#define PG8_LDA(dst, b, h) do { _Pragma("unroll") for (int m = 0; m < 4; ++m) _Pragma("unroll") for (int k = 0; k < 2; ++k) dst[m][k] = *(const LAS bf16x8*)(lds + PG8_SA(b, h) + aoff + m * 2048 + k * 1024); } while (0)
#define PG8_LDB(dst, b, h) do { _Pragma("unroll") for (int n = 0; n < 2; ++n) _Pragma("unroll") for (int k = 0; k < 2; ++k) dst[n][k] = *(const LAS bf16x8*)(lds + PG8_SB(b, h) + boff + n * 2048 + k * 1024); } while (0)
#define PG8_MMA(ai, bj, At, Bt) do { __builtin_amdgcn_s_setprio(1); _Pragma("unroll") for (int m = 0; m < 4; ++m) _Pragma("unroll") for (int n = 0; n < 2; ++n) _Pragma("unroll") for (int k = 0; k < 2; ++k) \
        acc[ai][bj][m][n] = __builtin_amdgcn_mfma_f32_16x16x32_bf16(Bt[n][k], At[m][k], acc[ai][bj][m][n], 0, 0, 0); __builtin_amdgcn_s_setprio(0); } while (0)
#define PG8_WAIT_V(n) asm volatile("s_waitcnt vmcnt(" #n ")" ::: "memory")
#define PG8_WAIT_L(n) asm volatile("s_waitcnt lgkmcnt(" #n ")" ::: "memory")
#define PG8_BAR __builtin_amdgcn_s_barrier()
#define PG8_SCHED __builtin_amdgcn_sched_barrier(0)
    Unit cur, nxt; int ui = 0;
    if (!S.next(0, cur)) return;
    if (!keep) {
#pragma unroll
    for (int a = 0; a < 2; ++a)
#pragma unroll
        for (int b = 0; b < 2; ++b)
#pragma unroll
            for (int m = 0; m < 4; ++m)
#pragma unroll
                for (int n = 0; n < 2; ++n) acc[a][b][m][n] = (f32x4){0.f, 0.f, 0.f, 0.f};
    }
    bf16x8 At[4][2], B0[2][2], B1[2][2];
    const char* cA = (const char*)g.A + (size_t)cur.pm * tstepA; const char* cB = (const char*)g.Bt + (size_t)cur.pn * tstepB;
    PG8_STAGE(PG8_SB(0, 0), cB, voffB); PG8_STAGE(PG8_SB(0, 1), cB + hstepB, voffB); PG8_STAGE(PG8_SA(0, 0), cA, voffA); PG8_STAGE(PG8_SA(0, 1), cA + hstepA, voffA);
    if (wr == 1) PG8_BAR;
    PG8_WAIT_V(2); PG8_BAR;
    PG8_STAGE(PG8_SB(1, 0), cB + kstep, voffB); PG8_STAGE(PG8_SA(1, 0), cA + kstep, voffA); PG8_STAGE(PG8_SB(1, 1), cB + hstepB + kstep, voffB);
    PG8_WAIT_V(6); PG8_BAR;
    for (;;) {
        const bool has_next = S.next(ui + 1, nxt);
        const char* nA = has_next ? (const char*)g.A + (size_t)nxt.pm * tstepA : cA; const char* nB = has_next ? (const char*)g.Bt + (size_t)nxt.pn * tstepB : cB;
        for (int t = 0; t < nt; t += 2) {
            const bool last = (t == nt - 2);
            const char* a1 = cA + (size_t)(t + 1) * kstep;
            const char* a2 = last ? nA : cA + (size_t)(t + 2) * kstep; const char* b2 = last ? nB : cB + (size_t)(t + 2) * kstep;
            const char* a3 = a2 + kstep; const char* b3 = b2 + kstep;
            PG8_LDB(B0, 0, 0); PG8_LDB(B1, 0, 1); PG8_SCHED; PG8_LDA(At, 0, 0); PG8_STAGE(PG8_SA(1, 1), a1 + hstepA, voffA);
            PG8_WAIT_V(8); PG8_WAIT_L(0); PG8_BAR; PG8_MMA(0, 0, At, B0); PG8_MMA(0, 1, At, B1); PG8_BAR; PG8_SCHED;
            PG8_LDA(At, 0, 1); PG8_STAGE(PG8_SB(0, 0), b2, voffB); PG8_STAGE(PG8_SB(0, 1), b2 + hstepB, voffB); PG8_STAGE(PG8_SA(0, 0), a2, voffA);
            PG8_WAIT_V(8); PG8_WAIT_L(0); PG8_BAR; PG8_MMA(1, 0, At, B0); PG8_MMA(1, 1, At, B1); PG8_BAR; PG8_SCHED;
            PG8_LDB(B0, 1, 0); PG8_LDB(B1, 1, 1); PG8_SCHED; PG8_LDA(At, 1, 0); PG8_STAGE(PG8_SA(0, 1), a2 + hstepA, voffA);
            PG8_WAIT_V(8); PG8_WAIT_L(0); PG8_BAR; PG8_MMA(0, 0, At, B0); PG8_MMA(0, 1, At, B1); PG8_BAR; PG8_SCHED;
            PG8_LDA(At, 1, 1); PG8_STAGE(PG8_SB(1, 0), b3, voffB); PG8_STAGE(PG8_SB(1, 1), b3 + hstepB, voffB); PG8_STAGE(PG8_SA(1, 0), a3, voffA);
            PG8_WAIT_V(8); PG8_WAIT_L(0); PG8_BAR; PG8_MMA(1, 0, At, B0); PG8_MMA(1, 1, At, B1); PG8_BAR; PG8_SCHED;
        }
        if constexpr (ALIGN_EPI) { if (wr == 0) PG8_BAR; }
        E(acc, cur, wr, wc, fr, fq);
        if (!has_next) break;
#pragma unroll
        for (int a = 0; a < 2; ++a)
#pragma unroll
            for (int b = 0; b < 2; ++b)
#pragma unroll
                for (int m = 0; m < 4; ++m)
#pragma unroll
                    for (int n = 0; n < 2; ++n) acc[a][b][m][n] = (f32x4){0.f, 0.f, 0.f, 0.f};
        cur = nxt; cA = nA; cB = nB; ++ui;
        if constexpr (ALIGN_EPI) { if (wr == 1) PG8_BAR; }
    }
    PG8_WAIT_V(0);
    if constexpr (!ALIGN_EPI) { if (wr == 0) PG8_BAR; }
    PG8_BAR;
#undef PG8_SA
#undef PG8_SB
#undef PG8_STAGE
#undef PG8_LDA
#undef PG8_LDB
#undef PG8_MMA
#undef PG8_WAIT_V
#undef PG8_WAIT_L
#undef PG8_BAR
#undef PG8_SCHED
}
template <class Epi, class Sched>
__device__ __forceinline__ void gemm_run(LAS unsigned char* lds, const Gemm g, const Sched& S, const Epi& E) {
    f32x4 acc[2][2][4][2];
    gemm_phase<Epi, Sched, true>(lds, g, S, E, acc, false);
}
}

typedef f32x4 (&AccRef)[2][2][4][2];

struct EpiGU {
    static constexpr bool PERM = true;
    bf16_t* act;
    __device__ __forceinline__ void operator()(AccRef acc, const pg8::Unit& u, int wr, int wc, int fr, int fq) const {
        asm volatile("" : "+v"(fr), "+v"(fq));
        const int row0 = u.pm * 256 + wr * 64 + fr, col0 = u.pn * 128 + wc * 32 + 8 * fq;
#pragma unroll
        for (int ai = 0; ai < 2; ++ai)
#pragma unroll
            for (int m = 0; m < 4; ++m) {
                f32x4 r[2];
#pragma unroll
                for (int n = 0; n < 2; ++n) {
                    const f32x4 gt = acc[ai][0][m][n], up = acc[ai][1][m][n];
#pragma unroll
                    for (int j = 0; j < 4; ++j) r[n][j] = gt[j] * __builtin_amdgcn_rcpf(1.0f + __expf(-gt[j])) * up[j];
                }
                *(u32x4*)(act + (size_t)(row0 + ai * 128 + m * 16) * DFF + col0) = pack8(r[0], r[1]);
            }
    }
};
struct EpiD {
    static constexpr bool PERM = false;
    const float* X; float* Z; float cs;
    __device__ __forceinline__ void operator()(AccRef acc, const pg8::Unit& u, int wr, int wc, int fr, int fq) const {
        asm volatile("" : "+v"(fr), "+v"(fq));
        const int row0 = u.pm * 256 + wr * 64 + fr, col0 = u.pn * 256 + wc * 32 + 4 * fq;
#pragma unroll
        for (int ai = 0; ai < 2; ++ai)
#pragma unroll
            for (int m = 0; m < 4; ++m) {
                const size_t off = (size_t)(row0 + ai * 128 + m * 16) * DM + col0;
#pragma unroll
                for (int bj = 0; bj < 2; ++bj)
#pragma unroll
                    for (int n = 0; n < 2; ++n) { const size_t o = off + bj * 128 + n * 16; const f32x4 x = *(const f32x4*)(X + o); *(f32x4*)(Z + o) = x * ALPHA + acc[ai][bj][m][n] * cs; }
            }
    }
};
struct EpiPart {
    static constexpr bool PERM = false;
    float* P;
    __device__ __forceinline__ void operator()(AccRef acc, const pg8::Unit& u, int wr, int wc, int fr, int fq) const {
        asm volatile("" : "+v"(fr), "+v"(fq));
        const int row0 = (u.pm - NP / 256) * 256 + wr * 64 + fr, col0 = u.pn * 256 + wc * 32 + 4 * fq;
#pragma unroll
        for (int ai = 0; ai < 2; ++ai)
#pragma unroll
            for (int m = 0; m < 4; ++m) {
                const size_t off = (size_t)(row0 + ai * 128 + m * 16) * DM + col0;
#pragma unroll
                for (int bj = 0; bj < 2; ++bj)
#pragma unroll
                    for (int n = 0; n < 2; ++n) *(f32x4*)(P + off + bj * 128 + n * 16) = acc[ai][bj][m][n];
            }
    }
};
struct EpiBRseg {
    static constexpr bool PERM = false;
    const bf16_t* G; bf16_t* MG; int b;
    __device__ __forceinline__ void operator()(AccRef acc, const pg8::Unit& u, int wr, int wc, int fr, int fq) const {
        asm volatile("" : "+v"(fr), "+v"(fq));
        const int row0 = u.pm * 256 + wr * 64 + fr, col0 = u.pn * 256 + wc * 32 + 4 * fq;
#pragma unroll
        for (int ai = 0; ai < 2; ++ai)
#pragma unroll
            for (int m = 0; m < 4; ++m) {
                const int row = row0 + ai * 128 + m * 16;
#pragma unroll
                for (int bj = 0; bj < 2; ++bj)
#pragma unroll
                    for (int n = 0; n < 2; ++n) {
                        const int c = col0 + bj * 128 + n * 16;
                        const bf16_t* gp = G + (size_t)row * 3072 + b * 1024 + c;
                        const u32x2 gw = *(const u32x2*)gp;
                        f32x4 gt; gt[0] = __uint_as_float(gw.x << 16); gt[1] = __uint_as_float(gw.x & 0xffff0000u); gt[2] = __uint_as_float(gw.y << 16); gt[3] = __uint_as_float(gw.y & 0xffff0000u);
                        if (b < 2) {
                            const u32x2 hw = *(const u32x2*)(gp + 1024);
                            f32x4 hn; hn[0] = __uint_as_float(hw.x << 16); hn[1] = __uint_as_float(hw.x & 0xffff0000u); hn[2] = __uint_as_float(hw.y << 16); hn[3] = __uint_as_float(hw.y & 0xffff0000u);
#pragma unroll
                            for (int j = 0; j < 4; ++j) acc[ai][bj][m][n][j] *= gt[j] * __builtin_amdgcn_rcpf(hn[j]);
                        } else {
                            const f32x4 v = gt * acc[ai][bj][m][n];
                            u32x2 w; w.x = pk2(v[0], v[1]); w.y = pk2(v[2], v[3]); *(u32x2*)(MG + (size_t)row * DM + c) = w;
                        }
                    }
                asm volatile("" ::: "memory");
            }
    }
};
struct EpiMem {
    static constexpr bool PERM = false;
    float* out; bf16_t* MKV;
    __device__ __forceinline__ void operator()(AccRef acc, const pg8::Unit& u, int wr, int wc, int fr, int fq) const {
        asm volatile("" : "+v"(fr), "+v"(fq));
        const int l = u.pn >> 1, kv = u.pn & 1;
        float* ob = out + (kv ? O_PMV : O_PMK) + (size_t)l * 1024 * 256;
        bf16_t* bb = MKV + (size_t)(l * 2 + kv) * 1024 * 256;
        const int row0 = u.pm * 256 + wr * 64 + fr, col0 = wc * 32 + 4 * fq;
#pragma unroll
        for (int ai = 0; ai < 2; ++ai)
#pragma unroll
            for (int m = 0; m < 4; ++m) {
                const size_t off = (size_t)(row0 + ai * 128 + m * 16) * 256 + col0;
#pragma unroll
                for (int bj = 0; bj < 2; ++bj)
#pragma unroll
                    for (int n = 0; n < 2; ++n) { const size_t o = off + bj * 128 + n * 16; const f32x4 v = acc[ai][bj][m][n]; *(f32x4*)(ob + o) = v; u32x2 w; w.x = pk2(v[0], v[1]); w.y = pk2(v[2], v[3]); *(u32x2*)(bb + o) = w; }
            }
    }
};
struct EpiIN {
    static constexpr bool PERM = true;
    bf16_t *XP, *Q, *Kb, *Vb, *XQ, *G; float* out; const float* rope; int l;
    __device__ __forceinline__ void operator()(AccRef acc, const pg8::Unit& u, int wr, int wc, int fr, int fq) const {
        asm volatile("" : "+v"(fr), "+v"(fq));
        const int pn = u.pn;
        const int row0 = u.pm * 256 + wr * 64 + fr;
        const int cl = wc * 32 + 8 * fq;
        const bool ropelane = ((wc & 1) == 0) && (fq < 2);
#pragma unroll
        for (int ai = 0; ai < 2; ++ai)
#pragma unroll
            for (int m = 0; m < 4; ++m) {
                const int row = row0 + ai * 128 + m * 16;
                const bool smp = row >= NP;
                const int b = smp ? ((row - NP) >> 3) : (row >> 12);
                const int t = smp ? ((row - NP) & 7) : (row & 4095);
#pragma unroll
                for (int bj = 0; bj < 2; ++bj) {
                    f32x4 v0 = acc[ai][bj][m][0], v1 = acc[ai][bj][m][1];
                    const int c = cl + 128 * bj;
                    if (pn == 0) {
                        *(u32x4*)(XP + (size_t)row * 256 + c) = pack8(v0, v1);
                        if (smp) { float* o = out + O_SP + ((size_t)(l * DB + b) * 15 + 7 + t) * 256 + c; *(f32x4*)o = v0; *(f32x4*)(o + 4) = v1; }
                        else if (t >= SEQ - 15) { float* o = out + O_PP + ((size_t)(l * NB + b) * 15 + (t - (SEQ - 15))) * 256 + c; *(f32x4*)o = v0; *(f32x4*)(o + 4) = v1; }
                    } else if (pn <= 3) {
                        const bool isv = (pn == 3) && (bj == 1);
                        if (!isv) {
                            f32x4 p0, p1;
#pragma unroll
                            for (int j = 0; j < 4; ++j) { p0[j] = __shfl_xor(v0[j], 16); p1[j] = __shfl_xor(v1[j], 16); }
                            if (ropelane) {
                                const float* tp = rope + (size_t)(smp ? SEQ + t : t) * 16;
                                const f32x4 c0 = *(const f32x4*)tp, c1 = *(const f32x4*)(tp + 4), s0 = *(const f32x4*)(tp + 8), s1 = *(const f32x4*)(tp + 12);
                                const float sg = (fq == 0) ? -1.f : 1.f;
                                v0 = v0 * c0 + p0 * s0 * sg; v1 = v1 * c1 + p1 * s1 * sg;
                            }
                        }
                        if (pn < 3) { *(u32x4*)(Q + (size_t)row * 512 + (pn - 1) * 256 + c) = pack8(v0 * 0.125f, v1 * 0.125f); }
                        else {
                            bf16_t* dst = (bj == 0) ? Kb : Vb;
                            *(u32x4*)(dst + (size_t)row * 128 + cl) = pack8(v0, v1);
                            if (smp) { float* o = out + (bj == 0 ? O_SK : O_SV) + ((size_t)(l * DB + b) * 128 + 120 + t) * 128 + cl; *(f32x4*)o = v0; *(f32x4*)(o + 4) = v1; }
                            else if (t >= SEQ - 128) { float* o = out + (bj == 0 ? O_PK : O_PV) + ((size_t)(l * NB + b) * 128 + (t - (SEQ - 128))) * 128 + cl; *(f32x4*)o = v0; *(f32x4*)(o + 4) = v1; }
                        }
                    } else if (pn == 4) {
                        *(u32x4*)(XQ + (size_t)row * 256 + c) = pack8(v0 * 0.125f, v1 * 0.125f);
                    } else {
#pragma unroll
                        for (int j = 0; j < 4; ++j) { v0[j] = __builtin_amdgcn_rcpf(1.0f + __expf(-v0[j])); v1[j] = __builtin_amdgcn_rcpf(1.0f + __expf(-v1[j])); }
                        *(u32x4*)(G + (size_t)row * 3072 + (pn - 5) * 256 + c) = pack8(v0, v1);
                    }
                }
            }
    }
};

__device__ __forceinline__ void transpose_item(const float* W, int N, int k0, int n0, bf16_t* dst, int ldd, LAS float* scr, int lane) {
#pragma unroll 8
    for (int i = 0; i < 32; ++i) { const int kk = 2 * i + (lane >> 5); scr[kk * 33 + (lane & 31)] = W[(size_t)(k0 + kk) * N + n0 + (lane & 31)]; }
    LDS_WAIT();
    const int c = lane & 7;
#pragma unroll
    for (int j = 0; j < 4; ++j) { const int n = (lane >> 3) + 8 * j; const LAS float* s = scr + (8 * c) * 33 + n;
        u32x4 o; o.x = pk2(s[0 * 33], s[1 * 33]); o.y = pk2(s[2 * 33], s[3 * 33]); o.z = pk2(s[4 * 33], s[5 * 33]); o.w = pk2(s[6 * 33], s[7 * 33]);
        *(u32x4*)(dst + (size_t)n * ldd + 8 * c) = o; }
    LDS_WAIT();
}
struct Job { const float* src; bf16_t* dst; int K, N, ldd, mode; };
__device__ __forceinline__ Job get_job(KP pp, int l, int ty) {
    const Params __attribute__((address_space(4)))& p = *pp;
    unsigned char* wl = p.ws + WS_W + (size_t)l * WL_STRIDE;
    Job j; j.mode = 0;
    switch (ty) {
    case 0: j.src = p.in[10] + (size_t)l * DM * DFF; j.dst = (bf16_t*)(wl + WL_GU1); j.K = DM; j.N = DFF; j.ldd = DM; j.mode = 1; break;
    case 1: j.src = p.in[11] + (size_t)l * DM * DFF; j.dst = (bf16_t*)(wl + WL_GU1); j.K = DM; j.N = DFF; j.ldd = DM; j.mode = 2; break;
    case 2: j.src = p.in[12] + (size_t)l * DFF * DM; j.dst = (bf16_t*)(wl + WL_D1); j.K = DFF; j.N = DM; j.ldd = DFF; break;
    case 3: j.src = p.in[15] + (size_t)l * DM * INC; j.dst = (bf16_t*)(wl + WL_IN); j.K = DM; j.N = INC; j.ldd = DM; break;
    case 4: j.src = p.in[19] + (size_t)l * 256 * DM; j.dst = (bf16_t*)(wl + WL_BR); j.K = 256; j.N = DM; j.ldd = DM; break;
    case 5: j.src = p.in[20] + (size_t)l * 512 * DM; j.dst = (bf16_t*)(wl + WL_BR) + 256; j.K = 512; j.N = DM; j.ldd = DM; break;
    case 6: j.src = p.in[21] + (size_t)l * 256 * DM; j.dst = (bf16_t*)(wl + WL_BR) + 768; j.K = 256; j.N = DM; j.ldd = DM; break;
    case 7: j.src = p.in[22] + (size_t)l * DM * DM; j.dst = (bf16_t*)(wl + WL_O); j.K = DM; j.N = DM; j.ldd = DM; break;
    case 8: j.src = p.in[25] + (size_t)l * DM * DFF; j.dst = (bf16_t*)(wl + WL_GU2); j.K = DM; j.N = DFF; j.ldd = DM; j.mode = 1; break;
    case 9: j.src = p.in[26] + (size_t)l * DM * DFF; j.dst = (bf16_t*)(wl + WL_GU2); j.K = DM; j.N = DFF; j.ldd = DM; j.mode = 2; break;
    case 10: j.src = p.in[27] + (size_t)l * DFF * DM; j.dst = (bf16_t*)(wl + WL_D2); j.K = DFF; j.N = DM; j.ldd = DFF; break;
    case 11: j.src = p.in[8] + (size_t)l * DM * 256; j.dst = (bf16_t*)(p.ws + WS_WMEM) + (size_t)(l * 2 + 0) * 256 * DM; j.K = DM; j.N = 256; j.ldd = DM; break;
    default: j.src = p.in[9] + (size_t)l * DM * 256; j.dst = (bf16_t*)(p.ws + WS_WMEM) + (size_t)(l * 2 + 1) * 256 * DM; j.K = DM; j.N = 256; j.ldd = DM; break;
    }
    return j;
}
__device__ __forceinline__ void prologue_phase(KP pp, LAS unsigned char* lds) {
    const Params __attribute__((address_space(4)))& p = *pp;
    int tid = threadIdx.x; asm volatile("" : "+v"(tid));
    const int lane = tid & 63, wave = tid >> 6;
    const int gw = blockIdx.x * 8 + wave, NGW = gridDim.x * 8;
    LAS float* scr = (LAS float*)(lds + wave * 16384);
    int base = 0;
#pragma nounroll
    for (int l = 0; l < DEPTH; ++l) {
#pragma nounroll
        for (int ty = 0; ty < 13; ++ty) {
            const Job j = get_job(pp, l, ty);
            const int nblk = j.N >> 5, nit = (j.K >> 6) * nblk;
            int it0 = (gw - base) % NGW; if (it0 < 0) it0 += NGW;
            for (int it = it0; it < nit; it += NGW) {
                const int kb = it / nblk, nb = it - kb * nblk, k0 = kb * 64, n0 = nb * 32;
                int drow = n0;
                if (j.mode) drow = 256 * (n0 >> 7) + (n0 & 127) + (j.mode == 2 ? 128 : 0);
                transpose_item(j.src, j.N, k0, n0, j.dst + (size_t)drow * j.ldd + k0, j.ldd, scr, lane);
            }
            base = (base + nit) % NGW;
        }
    }
    const int gt = blockIdx.x * 512 + tid, NGT = gridDim.x * 512;
    float* rope = (float*)(p.ws + WS_ROPE);
    for (int e = gt; e < (SEQ + DSEQ) * 8; e += NGT) {
        const int idx = e >> 3, i = e & 7; const int pos = idx < SEQ ? idx : 8192 + (idx - SEQ);
        const float angf = (float)pos * p.invf[i];
        const double a = (double)angf; const double TWO_PI = 6.283185307179586476925286766559;
        const double kq = __builtin_rint(a / TWO_PI); const double r = a - kq * TWO_PI; const double r2 = r * r;
        double sn = r, cs = 1.0, ts = r, tc = 1.0;
#pragma unroll 1
        for (int n = 1; n <= 15; ++n) { tc = -tc * r2 / (double)((2 * n - 1) * (2 * n)); ts = -ts * r2 / (double)((2 * n) * (2 * n + 1)); cs += tc; sn += ts; }
        rope[(size_t)idx * 16 + i] = (float)cs; rope[(size_t)idx * 16 + 8 + i] = (float)sn;
    }
    { const float* mp = p.in[7]; bf16_t* mb = (bf16_t*)(p.ws + WS_MEMB);
      for (int e = gt; e < 1024 * 1024 / 8; e += NGT) { const f32x4 a = *(const f32x4*)(mp + (size_t)e * 8), b = *(const f32x4*)(mp + (size_t)e * 8 + 4); *(u32x4*)(mb + (size_t)e * 8) = pack8(a, b); } }
    { bf16_t* xb = (bf16_t*)(p.ws + WS_XB); float* X = p.out + O_Y;
      for (int e = gt; e < MROWS * DM / 8; e += NGT) {
          const size_t o = (size_t)e * 8; const float* src = o < (size_t)NP * DM ? p.in[0] + o : p.in[1] + (o - (size_t)NP * DM);
          const f32x4 a = *(const f32x4*)src, b = *(const f32x4*)(src + 4); *(f32x4*)(X + o) = a; *(f32x4*)(X + o + 4) = b; *(u32x4*)(xb + o) = pack8(a, b); } }
}

__device__ __forceinline__ void ln_phase(const float* Z, float* X, bf16_t* XB, const float* g, const float* b, const float* part, int nparts, float cs) {
    int tid = threadIdx.x; asm volatile("" : "+v"(tid));
    const int lane = tid & 63, wave = tid >> 6;
    const int gw = blockIdx.x * 8 + wave, NGW = gridDim.x * 8;
    f32x4 gg[4], bb[4];
#pragma unroll
    for (int j = 0; j < 4; ++j) { gg[j] = *(const f32x4*)(g + 256 * j + 4 * lane); bb[j] = *(const f32x4*)(b + 256 * j + 4 * lane); }
    for (int row = gw; row < MROWS; row += NGW) {
        const f32x4* zr = (const f32x4*)(Z + (size_t)row * DM) + lane;
        f32x4 v[4]; float s = 0.f;
#pragma unroll
        for (int j = 0; j < 4; ++j) v[j] = (f32x4){0.f, 0.f, 0.f, 0.f};
        if (row < NP) {
#pragma unroll
            for (int j = 0; j < 4; ++j) v[j] = zr[64 * j];
        } else {
            const f32x4* xr = (const f32x4*)(X + (size_t)row * DM) + lane;
            f32x4 a[4];
#pragma unroll
            for (int j = 0; j < 4; ++j) a[j] = (f32x4){0.f, 0.f, 0.f, 0.f};
            for (int k = 0; k < nparts; ++k) { const f32x4* pr = (const f32x4*)(part + ((size_t)k * NSMP + (row - NP)) * DM) + lane;
#pragma unroll
                for (int j = 0; j < 4; ++j) a[j] += pr[64 * j]; }
#pragma unroll
            for (int j = 0; j < 4; ++j) v[j] = xr[64 * j] * ALPHA + a[j] * cs;
        }
#pragma unroll
        for (int j = 0; j < 4; ++j) s += (v[j][0] + v[j][1]) + (v[j][2] + v[j][3]);
        const float mean = wave_sum(s) * (1.f / DM); float s2 = 0.f;
#pragma unroll
        for (int j = 0; j < 4; ++j) { v[j] = v[j] - mean; s2 += (v[j][0] * v[j][0] + v[j][1] * v[j][1]) + (v[j][2] * v[j][2] + v[j][3] * v[j][3]); }
        const float rstd = 1.f / sqrtf(wave_sum(s2) * (1.f / DM) + LN_EPS);
        f32x4* xo = (f32x4*)(X + (size_t)row * DM) + lane; u32x2* bo = (u32x2*)(XB + (size_t)row * DM) + lane;
#pragma unroll
        for (int j = 0; j < 4; ++j) { const f32x4 o = v[j] * rstd * gg[j] + bb[j]; xo[64 * j] = o; u32x2 w; w.x = pk2(o[0], o[1]); w.y = pk2(o[2], o[3]); bo[64 * j] = w; }
    }
}

constexpr int KPITCH = 144;
constexpr int VPITCH = 520;
constexpr int LDS_KS = 0, LDS_VT = 256 * KPITCH;
__device__ __forceinline__ int crow(int i, int h) { return (i & 3) + 8 * (i >> 2) + 4 * h; }
__device__ __forceinline__ bf16x8 packrow(const f32x16& x, int s) {
    u32x4 w; w.x = pk2(x[8 * s + 0], x[8 * s + 1]); w.y = pk2(x[8 * s + 2], x[8 * s + 3]); w.z = pk2(x[8 * s + 4], x[8 * s + 5]); w.w = pk2(x[8 * s + 6], x[8 * s + 7]);
    return __builtin_bit_cast(bf16x8, w);
}
#define MFMA32(a, b, c) __builtin_amdgcn_mfma_f32_32x32x16_bf16((a), (b), (c), 0, 0, 0)
template <bool MASK>
__device__ __forceinline__ void attn_qtile(const LAS unsigned char* Ks, const LAS unsigned char* Vts, int c_lo, int c_hi, const bf16_t* qptr, int qi, float m_init, float l_init, bf16_t* optr, bool do_store, int lane) {
    const int r = lane & 31, h = lane >> 5;
    bf16x8 qf[4];
#pragma unroll
    for (int s = 0; s < 4; ++s) qf[s] = *(const bf16x8*)(qptr + 16 * s + 8 * h);
    f32x16 o0, o1;
#pragma unroll
    for (int i = 0; i < 16; ++i) { o0[i] = 0.f; o1[i] = 0.f; }
    float mrun = m_init, lrun = l_init;
#pragma nounroll
    for (int c = c_lo; c < c_hi; ++c) {
        const int kb = 64 * c;
        f32x16 s0, s1;
#pragma unroll
        for (int i = 0; i < 16; ++i) { s0[i] = 0.f; s1[i] = 0.f; }
#pragma unroll
        for (int s = 0; s < 4; ++s) {
            const bf16x8 k0 = *(const LAS bf16x8*)(Ks + (kb + r) * KPITCH + 32 * s + 16 * h);
            const bf16x8 k1 = *(const LAS bf16x8*)(Ks + (kb + 32 + r) * KPITCH + 32 * s + 16 * h);
            s0 = MFMA32(k0, qf[s], s0); s1 = MFMA32(k1, qf[s], s1);
        }
        if (MASK) {
#pragma unroll
            for (int i = 0; i < 16; ++i) { const int j0 = kb + crow(i, h), j1 = j0 + 32;
                if (!(j0 > qi && j0 <= qi + 128)) s0[i] = -INFINITY;
                if (!(j1 > qi && j1 <= qi + 128)) s1[i] = -INFINITY; }
        }
        float cm = fmaxf(s0[0], s1[0]);
#pragma unroll
        for (int i = 1; i < 16; ++i) cm = fmaxf(cm, fmaxf(s0[i], s1[i]));
        cm = fmaxf(cm, __shfl_xor(cm, 32));
        const float mn = fmaxf(mrun, cm);
        const float alpha = __expf(mrun - mn);
        mrun = mn;
        float ps = 0.f;
#pragma unroll
        for (int i = 0; i < 16; ++i) { s0[i] = __expf(s0[i] - mn); s1[i] = __expf(s1[i] - mn); ps += s0[i] + s1[i]; }
        lrun = lrun * alpha + ps;
#pragma unroll
        for (int i = 0; i < 16; ++i) { o0[i] *= alpha; o1[i] *= alpha; }
        const bf16x8 p00 = packrow(s0, 0), p01 = packrow(s0, 1), p10 = packrow(s1, 0), p11 = packrow(s1, 1);
#pragma unroll
        for (int dt = 0; dt < 2; ++dt) {
            const LAS unsigned char* vrow = Vts + (32 * dt + r) * VPITCH + (kb + 4 * h) * 2;
            f32x16 o = dt ? o1 : o0;
#pragma unroll
            for (int tt = 0; tt < 2; ++tt)
#pragma unroll
                for (int s2 = 0; s2 < 2; ++s2) {
                    const s16x4 lo = *(const LAS s16x4*)(vrow + (32 * tt + 16 * s2) * 2);
                    const s16x4 hi = *(const LAS s16x4*)(vrow + (32 * tt + 16 * s2 + 8) * 2);
                    const bf16x8 vf = __builtin_shufflevector(lo, hi, 0, 1, 2, 3, 4, 5, 6, 7);
                    const bf16x8 pf = tt ? (s2 ? p11 : p10) : (s2 ? p01 : p00);
                    o = MFMA32(vf, pf, o);
                }
            if (dt) o1 = o; else o0 = o;
        }
    }
    const float lt = lrun + __shfl_xor(lrun, 32);
    const float inv = 1.0f / lt;
    if (do_store) {
#pragma unroll
        for (int g4 = 0; g4 < 4; ++g4) {
            u32x2 w0, w1;
            w0.x = pk2(o0[4 * g4 + 0] * inv, o0[4 * g4 + 1] * inv); w0.y = pk2(o0[4 * g4 + 2] * inv, o0[4 * g4 + 3] * inv);
            w1.x = pk2(o1[4 * g4 + 0] * inv, o1[4 * g4 + 1] * inv); w1.y = pk2(o1[4 * g4 + 2] * inv, o1[4 * g4 + 3] * inv);
            *(u32x2*)(optr + 8 * g4 + 4 * h) = w0;
            *(u32x2*)(optr + 32 + 8 * g4 + 4 * h) = w1;
        }
    }
}
__device__ __forceinline__ u32x4 ld8_f32(const float* p) { const f32x4 a = *(const f32x4*)p, b = *(const f32x4*)(p + 4); return pack8(a, b); }
__device__ __forceinline__ void put_kv(LAS unsigned char* Ks, LAS unsigned char* Vts, int key, int ch, u32x4 kk, u32x4 vv) {
    *(LAS u32x4*)(Ks + key * KPITCH + ch * 16) = kk;
    LAS unsigned short* vp = (LAS unsigned short*)(Vts + (ch * 8) * VPITCH + key * 2);
    constexpr int VP2 = VPITCH / 2;
    vp[0 * VP2] = (unsigned short)(vv.x & 0xffffu); vp[1 * VP2] = (unsigned short)(vv.x >> 16);
    vp[2 * VP2] = (unsigned short)(vv.y & 0xffffu); vp[3 * VP2] = (unsigned short)(vv.y >> 16);
    vp[4 * VP2] = (unsigned short)(vv.z & 0xffffu); vp[5 * VP2] = (unsigned short)(vv.z >> 16);
    vp[6 * VP2] = (unsigned short)(vv.w & 0xffffu); vp[7 * VP2] = (unsigned short)(vv.w >> 16);
}

template <int W>
__device__ __forceinline__ void pool_rows(const float (&v)[23], bool prompt, int t0, LAS float* dsm, int rbase, int col) {
#pragma unroll
    for (int i = 0; i < 8; ++i) {
        float s = 0.f;
#pragma unroll
        for (int k = 0; k < W; ++k) s += v[15 + i - k];
        const int cnt = prompt ? ((t0 + i + 1) < W ? (t0 + i + 1) : W) : W;
        dsm[(rbase + i) * 256 + col] = s / (float)cnt - v[15 + i];
    }
}
__device__ __forceinline__ void mix_phase(KP pp, int l, LAS unsigned char* lds) {
    const Params __attribute__((address_space(4)))& p = *pp;
    int tid = threadIdx.x; asm volatile("" : "+v"(tid));
    const int lane = tid & 63, wave = __builtin_amdgcn_readfirstlane(tid >> 6);
    const bf16_t* XP = (const bf16_t*)(p.ws + WS_XP); const bf16_t* Q = (const bf16_t*)(p.ws + WS_Q);
    const bf16_t* Kb = (const bf16_t*)(p.ws + WS_K); const bf16_t* Vb = (const bf16_t*)(p.ws + WS_V);
    const bf16_t* XQ = (const bf16_t*)(p.ws + WS_XQ); bf16_t* Y = (bf16_t*)(p.ws + WS_YB);
    LAS unsigned char* Ks = lds + LDS_KS; LAS unsigned char* Vts = lds + LDS_VT;
    const float* sink = p.in[18] + l * 8;
    const int r = lane & 31;
    constexpr int NU = 256 + 256 + 256 + 512 + 544;
    for (int u = blockIdx.x; u < NU; u += gridDim.x) {
        __syncthreads();
        if (u < 256) {
            const int kvh = u & 1, blk = (u >> 1) & 31, b = u >> 6;
            const int jlo = blk == 0 ? 128 : 0;
            const size_t krow0 = (size_t)b * SEQ + (blk - 1) * 128;
            for (int it = tid + jlo * 8; it < 256 * 8; it += 512) { const int key = it >> 3, ch = it & 7;
                const size_t o = (krow0 + key) * 128 + kvh * 64 + ch * 8;
                put_kv(Ks, Vts, key, ch, *(const u32x4*)(Kb + o), *(const u32x4*)(Vb + o)); }
            __syncthreads();
#pragma nounroll
            for (int q2 = 0; q2 < 2; ++q2) {
                const int qt = wave * 2 + q2, g = qt >> 2, i0 = (qt & 3) * 32;
                int c_lo = i0 >= 64 ? 1 : 0, c_hi = i0 >= 64 ? 4 : 3; if (blk == 0) c_lo = 2;
                const size_t row = (size_t)b * SEQ + blk * 128 + i0 + r;
                const int hq = kvh * 4 + g;
                attn_qtile<true>(Ks, Vts, c_lo, c_hi, Q + row * 512 + hq * 64, i0 + r, sink[hq], (lane < 32) ? 1.f : 0.f, Y + row * 1024 + 256 + hq * 64, true, lane);
            }
        } else if (u < 512) {
            const int v = u - 256, head = v & 3, qb = (v >> 2) & 15, b = v >> 6;
            const bf16_t* mk = (const bf16_t*)(p.ws + WS_MEMKV) + (size_t)(l * 2 + 0) * 1024 * 256 + (size_t)b * 256 * 256 + head * 64;
            const bf16_t* mv = (const bf16_t*)(p.ws + WS_MEMKV) + (size_t)(l * 2 + 1) * 1024 * 256 + (size_t)b * 256 * 256 + head * 64;
            for (int it = tid; it < 256 * 8; it += 512) { const int key = it >> 3, ch = it & 7; const size_t o = (size_t)key * 256 + ch * 8;
                put_kv(Ks, Vts, key, ch, *(const u32x4*)(mk + o), *(const u32x4*)(mv + o)); }
            __syncthreads();
            const size_t row = (size_t)b * SEQ + qb * 256 + wave * 32 + r;
            attn_qtile<false>(Ks, Vts, 0, 4, XQ + row * 256 + head * 64, 0, -INFINITY, 0.f, Y + row * 1024 + 768 + head * 64, true, lane);
        } else if (u < 768) {
            const int v = u - 512, kvh = v & 1, b = v >> 1;
            const float* ck = p.in[2] + ((size_t)(l * DB + b) * 128) * 128 + kvh * 64;
            const float* cv = p.in[3] + ((size_t)(l * DB + b) * 128) * 128 + kvh * 64;
            float* ok = p.out + O_SK + ((size_t)(l * DB + b) * 128) * 128 + kvh * 64;
            float* ov = p.out + O_SV + ((size_t)(l * DB + b) * 128) * 128 + kvh * 64;
            for (int it = tid; it < 192 * 8; it += 512) { const int key = it >> 3, ch = it & 7;
                u32x4 kk = (u32x4){0u, 0u, 0u, 0u}, vv = (u32x4){0u, 0u, 0u, 0u};
                if (key < 128) {
                    const size_t o = (size_t)key * 128 + ch * 8;
                    const f32x4 ka = *(const f32x4*)(ck + o), kb2 = *(const f32x4*)(ck + o + 4), va = *(const f32x4*)(cv + o), vb2 = *(const f32x4*)(cv + o + 4);
                    kk = pack8(ka, kb2); vv = pack8(va, vb2);
                    if (key >= 8) { const size_t oo = (size_t)(key - 8) * 128 + ch * 8; *(f32x4*)(ok + oo) = ka; *(f32x4*)(ok + oo + 4) = kb2; *(f32x4*)(ov + oo) = va; *(f32x4*)(ov + oo + 4) = vb2; }
                } else if (key < 136) {
                    const size_t o = ((size_t)NP + b * 8 + (key - 128)) * 128 + kvh * 64 + ch * 8;
                    kk = *(const u32x4*)(Kb + o); vv = *(const u32x4*)(Vb + o);
                }
                put_kv(Ks, Vts, key, ch, kk, vv); }
            __syncthreads();
            if (wave == 0) {
                const int g = r >> 3, t = r & 7, hq = kvh * 4 + g;
                const size_t row = (size_t)NP + b * 8 + t;
                attn_qtile<true>(Ks, Vts, 0, 3, Q + row * 512 + hq * 64, t, sink[hq], (lane < 32) ? 1.f : 0.f, Y + row * 1024 + 256 + hq * 64, true, lane);
            }
        } else if (u < 1280) {
            const int v = u - 768, head = v & 3, b = v >> 2;
            const float* mk = p.in[5] + ((size_t)(l * DB + b) * 256) * 256 + head * 64;
            const float* mv = p.in[6] + ((size_t)(l * DB + b) * 256) * 256 + head * 64;
            for (int it = tid; it < 256 * 8; it += 512) { const int key = it >> 3, ch = it & 7; const size_t o = (size_t)key * 256 + ch * 8;
                put_kv(Ks, Vts, key, ch, ld8_f32(mk + o), ld8_f32(mv + o)); }
            __syncthreads();
            if (wave == 0) {
                const size_t row = (size_t)NP + b * 8 + (r & 7);
                attn_qtile<false>(Ks, Vts, 0, 4, XQ + row * 256 + head * 64, 0, -INFINITY, 0.f, Y + row * 1024 + 768 + head * 64, r < 8, lane);
            }
        } else {
            const int pc = u - 1280;
            LAS float* dsm = (LAS float*)lds;
            const int col = tid & 255, sub = tid >> 8, grp = col >> 6;
#pragma nounroll
            for (int gi = 0; gi < 2; ++gi) {
                const int g8 = sub * 2 + gi; const int R0 = pc * 32 + g8 * 8;
                float v[23]; bool prompt = R0 < NP; int t0 = 0;
                if (prompt) {
                    t0 = R0 & (SEQ - 1);
#pragma unroll
                    for (int k = 0; k < 23; ++k) v[k] = (t0 - 15 + k >= 0) ? bf2f(XP[(size_t)(R0 - 15 + k) * 256 + col]) : 0.f;
                } else {
                    const int sb = (R0 - NP) >> 3;
                    const float* sp = p.in[4] + ((size_t)(l * DB + sb) * 15) * 256 + col;
#pragma unroll
                    for (int k = 0; k < 15; ++k) v[k] = sp[(size_t)k * 256];
#pragma unroll
                    for (int k = 0; k < 8; ++k) v[15 + k] = bf2f(XP[(size_t)(R0 + k) * 256 + col]);
                    float* op = p.out + O_SP + ((size_t)(l * DB + sb) * 15) * 256 + col;
#pragma unroll
                    for (int k = 0; k < 7; ++k) op[(size_t)k * 256] = v[8 + k];
                }
                if (grp == 0) pool_rows<2>(v, prompt, t0, dsm, g8 * 8, col);
                else if (grp == 1) pool_rows<4>(v, prompt, t0, dsm, g8 * 8, col);
                else if (grp == 2) pool_rows<8>(v, prompt, t0, dsm, g8 * 8, col);
                else pool_rows<16>(v, prompt, t0, dsm, g8 * 8, col);
            }
            __syncthreads();
            const float* pm = p.in[16] + ((size_t)(l * 4 + grp) * 64) * 64 + (col & 63);
            float wreg[64];
#pragma unroll
            for (int c = 0; c < 64; ++c) wreg[c] = pm[c * 64];
            const float psc = p.in[17][l * 256 + col];
#pragma nounroll
            for (int rr = 0; rr < 16; ++rr) {
                const int row = sub * 16 + rr;
                const LAS f32x4* dp = (const LAS f32x4*)(dsm + row * 256 + grp * 64);
                float a = 0.f;
#pragma unroll
                for (int c4 = 0; c4 < 16; ++c4) { const f32x4 d = dp[c4]; a += d[0] * wreg[4 * c4] + d[1] * wreg[4 * c4 + 1] + d[2] * wreg[4 * c4 + 2] + d[3] * wreg[4 * c4 + 3]; }
                const unsigned w = pk2(a * psc, 0.f);
                Y[(size_t)(pc * 32 + row) * 1024 + col] = (bf16_t)(w & 0xffffu);
            }
        }
    }
}


#define XB_TMO      128
#define XB_XCNT(j)  (256  + 64 * (j))
#define XB_XSUB(j)  (1280 + 64 * (j))
#define XB_XGEN(j)  (2304 + 64 * (j))
#define XB_TOP      3328
#define XB_TOPGEN   3392
#define XCD_BAR_WORDS 3456
#define XB_SPIN_CAP (1u << 18)
__device__ __forceinline__ unsigned xb_ld(unsigned* p)              { return __hip_atomic_load(p, __ATOMIC_RELAXED, __HIP_MEMORY_SCOPE_AGENT); }
__device__ __forceinline__ unsigned xb_add(unsigned* p, unsigned v) { return __hip_atomic_fetch_add(p, v, __ATOMIC_RELAXED, __HIP_MEMORY_SCOPE_AGENT); }
__device__ __forceinline__ unsigned xb_xcc_id() { return (unsigned)__builtin_amdgcn_s_getreg((3 << 11) | 20) & 0xFu; }
#define XB_SPIN(cond, bar) do { unsigned _sp = 0; while (cond) { __builtin_amdgcn_s_sleep(1); \
    if ((++_sp & 255u) == 0u) { if (xb_ld(&(bar)[XB_TMO])) break; if (_sp > XB_SPIN_CAP) { atomicAdd(&(bar)[XB_TMO], 1u); break; } } } } while (0)
struct XcdBarrier { unsigned* bar; unsigned x; volatile LAS unsigned* st; };
__device__ __forceinline__ XcdBarrier xcd_barrier_post(unsigned* bar, volatile LAS unsigned* st) {
    XcdBarrier b; b.bar = bar; b.x = xb_xcc_id(); b.st = st;
    if (threadIdx.x == 0) (void)xb_add(&bar[XB_XCNT(b.x)], 1u);
    return b;
}
__device__ __forceinline__ void xcd_barrier_complete(unsigned* bar, unsigned x, unsigned& nloc, unsigned& nx) {
    const unsigned G = gridDim.x * gridDim.y * gridDim.z;
    unsigned sum, cnt, mine, sp = 0u;
    for (;;) {
        sum = 0u; cnt = 0u; mine = 0u;
#pragma unroll
        for (unsigned j = 0; j < 16; ++j) { const unsigned c = xb_ld(&bar[XB_XCNT(j)]); sum += c; cnt += (c > 0u) ? 1u : 0u; mine = (j == x) ? c : mine; }
        if (sum == G) break;
        __builtin_amdgcn_s_sleep(1);
        if ((++sp & 255u) == 0u) { if (xb_ld(&bar[XB_TMO])) break; if (sp > XB_SPIN_CAP) { atomicAdd(&bar[XB_TMO], 1u); break; } }
    }
    nloc = mine > 0u ? mine : 1u; nx = cnt > 0u ? cnt : 1u;
}
__device__ __forceinline__ void xcd_barrier(const XcdBarrier& b) {
    asm volatile("s_waitcnt vmcnt(0)" ::: "memory");
    __syncthreads();
    if (threadIdx.x == 0) {
        unsigned* bar = b.bar;
        __builtin_amdgcn_s_waitcnt(0);
        unsigned nloc = b.st[0], nx = b.st[1];
        if (nloc == 0u) { xcd_barrier_complete(bar, b.x, nloc, nx); b.st[0] = nloc; b.st[1] = nx; }
        const unsigned old = xb_add(&bar[XB_XSUB(b.x)], 1u);
        const unsigned gen = old / nloc;
        if (old + 1u == (gen + 1u) * nloc) {
            __builtin_amdgcn_fence(__ATOMIC_RELEASE, "agent");
            asm volatile("s_waitcnt vmcnt(0)" ::: "memory");
            const unsigned og = xb_add(&bar[XB_TOP], 1u);
            const unsigned tg = og / nx;
            if (og + 1u == (tg + 1u) * nx) xb_add(&bar[XB_TOPGEN], 1u);
            else XB_SPIN(xb_ld(&bar[XB_TOPGEN]) == tg, bar);
            __builtin_amdgcn_fence(__ATOMIC_ACQUIRE, "agent");
            xb_add(&bar[XB_XGEN(b.x)], 1u);
            asm volatile("s_waitcnt vmcnt(0)" ::: "memory");
        } else {
            XB_SPIN(xb_ld(&bar[XB_XGEN(b.x)]) == gen, bar);
            __builtin_amdgcn_fence(__ATOMIC_ACQUIRE, "agent");
            asm volatile("s_waitcnt vmcnt(0)" ::: "memory");
        }
    }
    __syncthreads();
}
constexpr int MISC_OFF = 131072 + 320;
constexpr size_t CTL_ZERO_BYTES = 16384;

__global__ void __launch_bounds__(512, 2) fwd_kernel(Params p_unused) {
    extern __shared__ __attribute__((aligned(16))) unsigned char lds_raw[];
    LAS unsigned char* lds = (LAS unsigned char*)lds_raw;
    const int G = gridDim.x, bx = blockIdx.x;
    if (threadIdx.x < 32) ((LAS unsigned*)(lds + MISC_OFF))[threadIdx.x] = 0u;
    __syncthreads();
    unsigned* barw; { KP pp0 = (KP)__builtin_amdgcn_kernarg_segment_ptr(); barw = (unsigned*)pp0->ws; }
    const XcdBarrier bar = xcd_barrier_post(barw, (volatile LAS unsigned*)(lds + MISC_OFF) + 8);
    int ph_lo, ph_hi;
    { KP pp0 = (KP)__builtin_amdgcn_kernarg_segment_ptr(); ph_lo = pp0->ph_lo; ph_hi = pp0->ph_hi; }
#pragma nounroll
    for (int ph = ph_lo; ph < ph_hi; ++ph) {
        if (ph > ph_lo) { if (ph == ph_lo + 1) cg::this_grid().sync(); else xcd_barrier(bar); }
        KP pp = (KP)__builtin_amdgcn_kernarg_segment_ptr(); asm volatile("" : "+s"(pp));
        const Params __attribute__((address_space(4)))& p = *pp;
        if (ph == 0) { prologue_phase(pp, lds); continue; }
        float* X = p.out + O_Y;
        bf16_t* XB = (bf16_t*)(p.ws + WS_XB); float* Z = (float*)(p.ws + WS_Z);
        bf16_t* ACT = (bf16_t*)(p.ws + WS_ACT);
        const int l = (ph - 1) / 11, sp = (ph - 1) % 11;
#pragma nounroll
        for (int rep = 0; rep < (((REP_MASK >> sp) & 1) ? 2 : 1); ++rep) {
        unsigned char* wl = p.ws + WS_W + (size_t)l * WL_STRIDE;
        if (sp == 0 || sp == 8) {
            pg8::Gemm g{XB, (const bf16_t*)(wl + (sp == 0 ? WL_GU1 : WL_GU2)), MROWS, 2 * DFF, DM, DM, DM};
            pg8::StaticOrder S; S.init(MROWS, 2 * DFF, G, bx);
            EpiGU E{ACT};
            pg8::gemm_run<EpiGU, pg8::StaticOrder>(lds, g, S, E);
            if (ph == 1 && bx >= G - 32) {
                pg8::Gemm g2{(const bf16_t*)(p.ws + WS_MEMB), (const bf16_t*)(p.ws + WS_WMEM), 1024, 2048, DM, DM, DM};
                pg8::StaticOrder S2; S2.init(1024, 2048, 32, bx - (G - 32));
                EpiMem E2{p.out, (bf16_t*)(p.ws + WS_MEMKV)};
                pg8::gemm_run<EpiMem, pg8::StaticOrder>(lds, g2, S2, E2);
            }
        } else if (sp == 1 || sp == 9 || sp == 6) {
            const bf16_t* Aop = sp == 6 ? (const bf16_t*)(p.ws + WS_MG) : ACT;
            const bf16_t* Bop = (const bf16_t*)(wl + (sp == 6 ? WL_O : (sp == 1 ? WL_D1 : WL_D2)));
            const int kdim = sp == 6 ? DM : DFF, nsplit = kdim / 256;
            {
                pg8::Gemm g{Aop, Bop, NP, DM, kdim, kdim, kdim};
                pg8::StaticOrder S; S.init(NP, DM, G, bx);
                EpiD E{X, Z, sp == 6 ? 1.0f : 0.5f};
                pg8::gemm_run<EpiD, pg8::StaticOrder>(lds, g, S, E);
            }
            if (bx < 16 * nsplit) {
                const int ks = bx >> 4, un = bx & 15;
                pg8::Gemm g{Aop + ks * 256, Bop + ks * 256, MROWS, DM, 256, kdim, kdim};
                pg8::SingleOrder S1{{NP / 256 + (un >> 2), un & 3}};
                EpiPart E{(float*)(p.ws + (sp == 6 ? WS_PART_O : WS_PART_D)) + (size_t)ks * NSMP * DM};
                pg8::gemm_run<EpiPart, pg8::SingleOrder>(lds, g, S1, E);
            }
        } else if (sp == 2 || sp == 7 || sp == 10) {
            const int gi = sp == 2 ? 13 : (sp == 7 ? 23 : 28);
            ln_phase(Z, X, XB, p.in[gi] + l * DM, p.in[gi + 1] + l * DM, (const float*)(p.ws + (sp == 7 ? WS_PART_O : WS_PART_D)), sp == 7 ? DM / 256 : DFF / 256, sp == 7 ? 1.0f : 0.5f);
        } else if (sp == 3) {
            pg8::Gemm g{XB, (const bf16_t*)(wl + WL_IN), MROWS, INC, DM, DM, DM};
            pg8::StaticOrder S; S.init(MROWS, INC, G, bx);
            EpiIN E{(bf16_t*)(p.ws + WS_XP), (bf16_t*)(p.ws + WS_Q), (bf16_t*)(p.ws + WS_K), (bf16_t*)(p.ws + WS_V), (bf16_t*)(p.ws + WS_XQ), (bf16_t*)(p.ws + WS_G), p.out, (const float*)(p.ws + WS_ROPE), l};
            pg8::gemm_run<EpiIN, pg8::StaticOrder>(lds, g, S, E);
        } else if (sp == 4) {
            mix_phase(pp, l, lds);
        } else {
            pg8::StaticOrder S; S.init(NP, DM, G, bx);
            f32x4 acc[2][2][4][2];
#pragma nounroll
            for (int ui = 0; ui < (bx < 16 ? 2 : 1); ++ui) {
                pg8::Unit u;
                if (ui == 0) { if (!S.next(0, u)) break; } else { u.pm = NP / 256 + (bx >> 2); u.pn = bx & 3; }
#pragma unroll
                for (int i0 = 0; i0 < 2; ++i0)
#pragma unroll
                    for (int i1 = 0; i1 < 2; ++i1)
#pragma unroll
                        for (int i2 = 0; i2 < 4; ++i2)
#pragma unroll
                            for (int i3 = 0; i3 < 2; ++i3) acc[i0][i1][i2][i3] = (f32x4){0.f, 0.f, 0.f, 0.f};
#pragma nounroll
                for (int b = 0; b < 3; ++b) {
                    const int koff = b == 0 ? 0 : (b == 1 ? 256 : 768), kk = b == 1 ? 512 : 256;
                    pg8::Gemm g{(const bf16_t*)(p.ws + WS_YB) + koff, (const bf16_t*)(wl + WL_BR) + koff, MROWS, DM, kk, DM, DM};
                    pg8::SingleOrder S1{u};
                    EpiBRseg E{(const bf16_t*)(p.ws + WS_G), (bf16_t*)(p.ws + WS_MG), b};
                    pg8::gemm_phase<EpiBRseg, pg8::SingleOrder, true>(lds, g, S1, E, acc, true);
                }
            }
        }
        }
    }
}

extern "C" void kernel_launch(void* const* d_in, const int* in_sizes, int n_in, void* d_out, int out_size, void* d_ws, size_t ws_size, hipStream_t stream) {
    static int grid = 0;
    if (grid == 0) {
        if (n_in != 30 || (size_t)out_size != O_END || ws_size < WS_END) { fprintf(stderr, "kernel_launch: unexpected shapes: n_in %d out %d ws %zu (need %zu)\n", n_in, out_size, ws_size, (size_t)WS_END); grid = -1; return; }
        int dev = 0, cus = 0, per_cu = 0;
        hipGetDevice(&dev); hipDeviceGetAttribute(&cus, hipDeviceAttributeMultiprocessorCount, dev);
        if (hipFuncSetAttribute((const void*)fwd_kernel, hipFuncAttributeMaxDynamicSharedMemorySize, LDS_BYTES) != hipSuccess) { fprintf(stderr, "kernel_launch: hipFuncSetAttribute failed\n"); grid = -1; return; }
        hipOccupancyMaxActiveBlocksPerMultiprocessor(&per_cu, (const void*)fwd_kernel, 512, LDS_BYTES);
        (void)hipGetLastError();
        if (per_cu < 1) { fprintf(stderr, "kernel_launch: occupancy query says %d blocks per CU\n", per_cu); per_cu = 1; }
        grid = cus;
    }
    if (grid < 0) return;
    if (hipMemsetAsync(d_ws, 0, CTL_ZERO_BYTES, stream) != hipSuccess) { fprintf(stderr, "kernel_launch: memset failed\n"); return; }
    Params p{};
    for (int i = 0; i < 30; ++i) p.in[i] = (const float*)d_in[i];
    p.out = (float*)d_out; p.ws = (unsigned char*)d_ws;
    for (int i = 0; i < 8; ++i) p.invf[i] = powf(500000.0f, -(float)i * 0.125f);
#if MK_MULTI
    for (int ph = 0; ph < NPHASE; ++ph) { p.ph_lo = ph; p.ph_hi = ph + 1; hipLaunchKernelGGL(fwd_kernel, dim3(grid), dim3(512), LDS_BYTES, stream, p); }
#else
    p.ph_lo = 0; p.ph_hi = NPHASE;
    void* args[] = {&p};
    hipError_t e = hipLaunchCooperativeKernel((const void*)fwd_kernel, dim3(grid), dim3(512), args, LDS_BYTES, stream);
    if (e != hipSuccess) fprintf(stderr, "kernel_launch: cooperative launch failed: %s (grid %d)\n", hipGetErrorString(e), grid);
#endif
}
```

```cpp
#include <hip/hip_runtime.h>
#include <hip/hip_cooperative_groups.h>
#include <cstdio>
#include <cstdint>
#include <cmath>
namespace cg = cooperative_groups;

#ifndef MK_MULTI
#define MK_MULTI 0
#endif

#ifndef PROBE_SEL
#define PROBE_SEL 0
#endif
#ifndef REP_MASK
#define REP_MASK 0
#endif
#define LAS __attribute__((address_space(3)))
typedef unsigned short bf16_t;
typedef short bf16x8 __attribute__((ext_vector_type(8)));
typedef short s16x4 __attribute__((ext_vector_type(4)));
typedef float f32x2 __attribute__((ext_vector_type(2)));
typedef float f32x4 __attribute__((ext_vector_type(4)));
typedef float f32x16 __attribute__((ext_vector_type(16)));
typedef unsigned u32x2 __attribute__((ext_vector_type(2)));
typedef unsigned u32x4 __attribute__((ext_vector_type(4)));
typedef __bf16 bf16x2_t __attribute__((ext_vector_type(2)));

constexpr int DM = 1024, NP = 16384, NSMP = 1024, MROWS = NP + NSMP, DEPTH = 4, DFF = 2816, INC = 4352;
constexpr int SEQ = 4096, NB = 4, DB = 128, DSEQ = 8;
constexpr float ALPHA = 1.6817928305074290f;
constexpr float LN_EPS = 1e-5f;
constexpr size_t O_Y = 0;
constexpr size_t O_PK = (size_t)MROWS * DM;
constexpr size_t O_PV = O_PK + (size_t)DEPTH * NB * 128 * 128;
constexpr size_t O_PP = O_PV + (size_t)DEPTH * NB * 128 * 128;
constexpr size_t O_PMK = O_PP + (size_t)DEPTH * NB * 15 * 256;
constexpr size_t O_PMV = O_PMK + (size_t)DEPTH * NB * 256 * 256;
constexpr size_t O_SK = O_PMV + (size_t)DEPTH * NB * 256 * 256;
constexpr size_t O_SV = O_SK + (size_t)DEPTH * DB * 128 * 128;
constexpr size_t O_SP = O_SV + (size_t)DEPTH * DB * 128 * 128;
constexpr size_t O_END = O_SP + (size_t)DEPTH * DB * 15 * 256;

constexpr size_t MiB = 1u << 20;
constexpr size_t WS_ROPE = 1 * MiB;
constexpr size_t WS_W = 2 * MiB;
constexpr size_t WL_GU1 = 0, WL_D1 = 11 * MiB, WL_IN = WL_D1 + 11 * MiB / 2, WL_BR = WL_IN + 17 * MiB / 2, WL_O = WL_BR + 2 * MiB,
                 WL_GU2 = WL_O + 2 * MiB, WL_D2 = WL_GU2 + 11 * MiB, WL_STRIDE = WL_D2 + 11 * MiB / 2;
constexpr size_t WS_WMEM = WS_W + 4 * WL_STRIDE;
constexpr size_t WS_MEMB = WS_WMEM + 4 * MiB;
constexpr size_t WS_MEMKV = WS_MEMB + 2 * MiB;
constexpr size_t WS_XB = WS_MEMKV + 4 * MiB;
constexpr size_t WS_Z = WS_XB + 34 * MiB;
constexpr size_t WS_R = WS_Z + 68 * MiB;
constexpr size_t WS_ACT = WS_R;
constexpr size_t WS_XP = WS_R;
constexpr size_t WS_Q = WS_XP + (size_t)MROWS * 256 * 2;
constexpr size_t WS_K = WS_Q + (size_t)MROWS * 512 * 2;
constexpr size_t WS_V = WS_K + (size_t)MROWS * 128 * 2;
constexpr size_t WS_XQ = WS_V + (size_t)MROWS * 128 * 2;
constexpr size_t WS_G = WS_XQ + (size_t)MROWS * 256 * 2;
constexpr size_t WS_YB = WS_G + (size_t)MROWS * 3072 * 2;
constexpr size_t WS_MG = WS_YB + (size_t)MROWS * 1024 * 2;
constexpr size_t WS_END = WS_MG + (size_t)MROWS * 1024 * 2;
constexpr size_t WS_PART_D = WS_R + 100 * MiB;
constexpr size_t WS_PART_O = WS_R;
static_assert(WS_ACT + (size_t)MROWS * DFF * 2 <= WS_PART_D && WS_PART_D + 11 * 4 * MiB <= WS_END && WS_PART_O + 16 * MiB <= WS_G, "overlay");
static_assert(WS_END <= 512 * MiB, "workspace");

constexpr int LDS_BYTES = 147456;
constexpr int NPHASE = 1 + 11 * DEPTH;

struct Params { const float* in[30]; float* out; unsigned char* ws; float invf[8]; int ph_lo, ph_hi; };
typedef const Params __attribute__((address_space(4)))* KP;

__device__ __forceinline__ unsigned pk2(float lo, float hi) { f32x2 v = {lo, hi}; bf16x2_t b = __builtin_convertvector(v, bf16x2_t); return __builtin_bit_cast(unsigned, b); }
__device__ __forceinline__ float bf2f(unsigned short b) { return __uint_as_float(((unsigned)b) << 16); }
__device__ __forceinline__ u32x4 pack8(f32x4 a, f32x4 b) { u32x4 w; w.x = pk2(a[0], a[1]); w.y = pk2(a[2], a[3]); w.z = pk2(b[0], b[1]); w.w = pk2(b[2], b[3]); return w; }
__device__ __forceinline__ float wave_sum(float v) {
#pragma unroll
    for (int o = 1; o < 64; o <<= 1) v += __shfl_xor(v, o);
    return v;
}
#define LDS_WAIT() asm volatile("s_waitcnt lgkmcnt(0)" ::: "memory")

namespace pg8 {
constexpr int BM = 256, BK = 64, HALF = 128, HTB = HALF * BK * 2, STAGE_BYTES = 8 * HTB, NXCD = 8, WGM = 8;
__host__ __device__ __forceinline__ int lds_byte(int r, int c) { const int st = (r >> 4) * 2 + (c >> 5), rr = r & 15, cc = c & 31, ob = rr * 64 + cc * 2; return st * 1024 + (ob ^ (((ob >> 9) & 1) << 5)); }
__host__ __device__ __forceinline__ void stage_rc(int b, int& R, int& C) { const int st = b / 1024, sb = b % 1024, swz = sb ^ (((sb >> 9) & 1) << 5); R = (st >> 1) * 16 + swz / 64; C = (st & 1) * 32 + (swz % 64) / 2; }
__host__ __device__ __forceinline__ int perm32(int rho) { const int n = rho >> 4, i = rho & 15; return 8 * (i >> 2) + 4 * n + (i & 3); }

struct Unit { int pm, pn; };
struct Gemm { const bf16_t* A; const bf16_t* Bt; int M, N, K, lda, ldb; };

struct StaticOrder {
    int nM, nN, nwg, G, c;
    __device__ void init(int M, int N, int G_, int c_) { nM = M / BM; nN = N / BM; nwg = nM * nN; G = G_; c = c_; }
    __device__ bool next(int i, Unit& u) const {
        const long L = (long)i * G + c; if (L >= nwg) return false;
        int wgid = (int)L; { const int q = nwg / NXCD, r = nwg % NXCD, xcd = wgid % NXCD, off = wgid / NXCD; wgid = (xcd < r ? xcd * (q + 1) : r * (q + 1) + (xcd - r) * q) + off; }
        const int nig = WGM * nN, gid = wgid / nig, fm = gid * WGM, gsz = (nM - fm) < WGM ? (nM - fm) : WGM;
        u.pm = fm + ((wgid % nig) % gsz); u.pn = (wgid % nig) / gsz; return true;
    }
};

struct SingleOrder {
    Unit u;
    __device__ bool next(int i, Unit& o) const { if (i) return false; o = u; return true; }
};
struct TailOrder {
    StaticOrder S; int c;
    __device__ bool next(int i, Unit& o) const { if (i == 0) return S.next(0, o); if (i == 1 && c < 16) { o.pm = NP / 256 + (c >> 2); o.pn = c & 3; return true; } return false; }
};
template <class Epi, class Sched, bool ALIGN_EPI, bool HOOK = false>
__device__ __forceinline__ void gemm_phase(LAS unsigned char* lds, const Gemm g, const Sched& S, const Epi& E, f32x4 (&acc)[2][2][4][2], bool keep) {
    int tid = threadIdx.x; asm volatile("" : "+v"(tid));
    const int wid = __builtin_amdgcn_readfirstlane(tid >> 6), lane = tid & 63, wr = wid >> 2, wc = wid & 3, fr = lane & 15, fq = lane >> 4;
    const int K = g.K, nt = K / BK;
    unsigned voffA[2], voffB[2];
#pragma unroll
    for (int i = 0; i < 2; ++i) { int R, C; stage_rc(tid * 16 + i * 8192, R, C); const int Rb = Epi::PERM ? ((R & ~31) + perm32(R & 31)) : R;
        voffA[i] = (unsigned)(R * g.lda + C) * 2u; voffB[i] = (unsigned)(Rb * g.ldb + C) * 2u; }
    const size_t kstep = (size_t)(BK * 2);
    const size_t hstepA = (size_t)HALF * g.lda * 2, hstepB = (size_t)HALF * g.ldb * 2;
    const size_t tstepA = 2 * hstepA, tstepB = 2 * hstepB;
    const unsigned ldsw = (unsigned)wid * 1024u;
    const int aoff = lds_byte(wr * 64 + fr, fq * 8), boff = lds_byte(wc * 32 + fr, fq * 8);
#define PG8_SA(b, h) (((b) * 2 + (h)) * HTB)
#define PG8_SB(b, h) ((4 + (b) * 2 + (h)) * HTB)
#define PG8_STAGE(bufoff, gbase, voff) do { _Pragma("unroll") for (int _i = 0; _i < 2; ++_i) \
        __builtin_amdgcn_global_load_lds((const unsigned*)((const char*)(gbase) + (voff)[_i]), (LAS unsigned*)(lds + (bufoff) + ldsw + _i * 8192), 16, 0, 0); } while (0)
#define PG8_LDA(dst, b, h) do { _Pragma("unroll") for (int m = 0; m < 4; ++m) _Pragma("unroll") for (int k = 0; k < 2; ++k) dst[m][k] = *(const LAS bf16x8*)(lds + PG8_SA(b, h) + aoff + m * 2048 + k * 1024); } while (0)
#define PG8_LDB(dst, b, h) do { _Pragma("unroll") for (int n = 0; n < 2; ++n) _Pragma("unroll") for (int k = 0; k < 2; ++k) dst[n][k] = *(const LAS bf16x8*)(lds + PG8_SB(b, h) + boff + n * 2048 + k * 1024); } while (0)
#define PG8_MMA(ai, bj, At, Bt) do { __builtin_amdgcn_s_setprio(1); _Pragma("unroll") for (int m = 0; m < 4; ++m) _Pragma("unroll") for (int n = 0; n < 2; ++n) _Pragma("unroll") for (int k = 0; k < 2; ++k) \
        acc[ai][bj][m][n] = __builtin_amdgcn_mfma_f32_16x16x32_bf16(Bt[n][k], At[m][k], acc[ai][bj][m][n], 0, 0, 0); __builtin_amdgcn_s_setprio(0); } while (0)
#define PG8_WAIT_V(n) asm volatile("s_waitcnt vmcnt(" #n ")" ::: "memory")
#define PG8_WAIT_L(n) asm volatile("s_waitcnt lgkmcnt(" #n ")" ::: "memory")
#define PG8_BAR __builtin_amdgcn_s_barrier()
#define PG8_SCHED __builtin_amdgcn_sched_barrier(0)
    Unit cur, nxt; int ui = 0;
    if (!S.next(0, cur)) return;
    if (!keep) {
#pragma unroll
    for (int a = 0; a < 2; ++a)
#pragma unroll
        for (int b = 0; b < 2; ++b)
#pragma unroll
            for (int m = 0; m < 4; ++m)
#pragma unroll
                for (int n = 0; n < 2; ++n) acc[a][b][m][n] = (f32x4){0.f, 0.f, 0.f, 0.f};
    }
    bf16x8 At[4][2], B0[2][2], B1[2][2];
    const char* cA = (const char*)g.A + (size_t)cur.pm * tstepA; const char* cB = (const char*)g.Bt + (size_t)cur.pn * tstepB;
    PG8_STAGE(PG8_SB(0, 0), cB, voffB); PG8_STAGE(PG8_SB(0, 1), cB + hstepB, voffB); PG8_STAGE(PG8_SA(0, 0), cA, voffA); PG8_STAGE(PG8_SA(0, 1), cA + hstepA, voffA);
    if (wr == 1) PG8_BAR;
    PG8_WAIT_V(2); PG8_BAR;
    PG8_STAGE(PG8_SB(1, 0), cB + kstep, voffB); PG8_STAGE(PG8_SA(1, 0), cA + kstep, voffA); PG8_STAGE(PG8_SB(1, 1), cB + hstepB + kstep, voffB);
    PG8_WAIT_V(6); PG8_BAR;
    for (;;) {
        const bool has_next = S.next(ui + 1, nxt);
        const char* nA = has_next ? (const char*)g.A + (size_t)nxt.pm * tstepA : cA; const char* nB = has_next ? (const char*)g.Bt + (size_t)nxt.pn * tstepB : cB;
        for (int t = 0; t < nt; t += 2) {
            if constexpr (HOOK) { if (t == 4 || t == 12) E.mid(acc, cur, t == 4 ? 0 : 1, wr, wc, fr, fq); }
            const bool last = (t == nt - 2);
            const char* a1 = cA + (size_t)(t + 1) * kstep;
            const char* a2 = last ? nA : cA + (size_t)(t + 2) * kstep; const char* b2 = last ? nB : cB + (size_t)(t + 2) * kstep;
            const char* a3 = a2 + kstep; const char* b3 = b2 + kstep;
            PG8_LDB(B0, 0, 0); PG8_LDB(B1, 0, 1); PG8_SCHED; PG8_LDA(At, 0, 0); PG8_STAGE(PG8_SA(1, 1), a1 + hstepA, voffA);
            PG8_WAIT_V(8); PG8_WAIT_L(0); PG8_BAR; PG8_MMA(0, 0, At, B0); PG8_MMA(0, 1, At, B1); PG8_BAR; PG8_SCHED;
            PG8_LDA(At, 0, 1); PG8_STAGE(PG8_SB(0, 0), b2, voffB); PG8_STAGE(PG8_SB(0, 1), b2 + hstepB, voffB); PG8_STAGE(PG8_SA(0, 0), a2, voffA);
            PG8_WAIT_V(8); PG8_WAIT_L(0); PG8_BAR; PG8_MMA(1, 0, At, B0); PG8_MMA(1, 1, At, B1); PG8_BAR; PG8_SCHED;
            PG8_LDB(B0, 1, 0); PG8_LDB(B1, 1, 1); PG8_SCHED; PG8_LDA(At, 1, 0); PG8_STAGE(PG8_SA(0, 1), a2 + hstepA, voffA);
            PG8_WAIT_V(8); PG8_WAIT_L(0); PG8_BAR; PG8_MMA(0, 0, At, B0); PG8_MMA(0, 1, At, B1); PG8_BAR; PG8_SCHED;
            PG8_LDA(At, 1, 1); PG8_STAGE(PG8_SB(1, 0), b3, voffB); PG8_STAGE(PG8_SB(1, 1), b3 + hstepB, voffB); PG8_STAGE(PG8_SA(1, 0), a3, voffA);
            PG8_WAIT_V(8); PG8_WAIT_L(0); PG8_BAR; PG8_MMA(1, 0, At, B0); PG8_MMA(1, 1, At, B1); PG8_BAR; PG8_SCHED;
        }
        if constexpr (ALIGN_EPI) { if (wr == 0) PG8_BAR; }
        E(acc, cur, wr, wc, fr, fq);
        if (!has_next) break;
#pragma unroll
        for (int a = 0; a < 2; ++a)
#pragma unroll
            for (int b = 0; b < 2; ++b)
#pragma unroll
                for (int m = 0; m < 4; ++m)
#pragma unroll
                    for (int n = 0; n < 2; ++n) acc[a][b][m][n] = (f32x4){0.f, 0.f, 0.f, 0.f};
        cur = nxt; cA = nA; cB = nB; ++ui;
        if constexpr (ALIGN_EPI) { if (wr == 1) PG8_BAR; }
    }
    PG8_WAIT_V(0);
    if constexpr (!ALIGN_EPI) { if (wr == 0) PG8_BAR; }
    PG8_BAR;
#undef PG8_SA
#undef PG8_SB
#undef PG8_STAGE
#undef PG8_LDA
#undef PG8_LDB
#undef PG8_MMA
#undef PG8_WAIT_V
#undef PG8_WAIT_L
#undef PG8_BAR
#undef PG8_SCHED
}
template <class Epi, class Sched>
__device__ __forceinline__ void gemm_run(LAS unsigned char* lds, const Gemm g, const Sched& S, const Epi& E) {
    f32x4 acc[2][2][4][2];
    gemm_phase<Epi, Sched, true>(lds, g, S, E, acc, false);
}
}

typedef f32x4 (&AccRef)[2][2][4][2];

struct EpiGU {
    static constexpr bool PERM = true;
    bf16_t* act;
    __device__ __forceinline__ void operator()(AccRef acc, const pg8::Unit& u, int wr, int wc, int fr, int fq) const {
        asm volatile("" : "+v"(fr), "+v"(fq));
        const int row0 = u.pm * 256 + wr * 64 + fr, col0 = u.pn * 128 + wc * 32 + 8 * fq;
#pragma unroll
        for (int ai = 0; ai < 2; ++ai)
#pragma unroll
            for (int m = 0; m < 4; ++m) {
                f32x4 r[2];
#pragma unroll
                for (int n = 0; n < 2; ++n) {
                    const f32x4 gt = acc[ai][0][m][n], up = acc[ai][1][m][n];
#pragma unroll
                    for (int j = 0; j < 4; ++j) r[n][j] = gt[j] * __builtin_amdgcn_rcpf(1.0f + __expf(-gt[j])) * up[j];
                }
                *(u32x4*)(act + (size_t)(row0 + ai * 128 + m * 16) * DFF + col0) = pack8(r[0], r[1]);
            }
    }
};
struct EpiD {
    static constexpr bool PERM = false;
    const float* X; float* Z; float cs;
    __device__ __forceinline__ void operator()(AccRef acc, const pg8::Unit& u, int wr, int wc, int fr, int fq) const {
        asm volatile("" : "+v"(fr), "+v"(fq));
        const int row0 = u.pm * 256 + wr * 64 + fr, col0 = u.pn * 256 + wc * 32 + 4 * fq;
#pragma unroll
        for (int ai = 0; ai < 2; ++ai)
#pragma unroll
            for (int m = 0; m < 4; ++m) {
                const size_t off = (size_t)(row0 + ai * 128 + m * 16) * DM + col0;
#pragma unroll
                for (int bj = 0; bj < 2; ++bj)
#pragma unroll
                    for (int n = 0; n < 2; ++n) { const size_t o = off + bj * 128 + n * 16; const f32x4 x = *(const f32x4*)(X + o); *(f32x4*)(Z + o) = x * ALPHA + acc[ai][bj][m][n] * cs; }
            }
    }
};
struct EpiPart {
    static constexpr bool PERM = false;
    float* P;
    __device__ __forceinline__ void operator()(AccRef acc, const pg8::Unit& u, int wr, int wc, int fr, int fq) const {
        asm volatile("" : "+v"(fr), "+v"(fq));
        const int row0 = (u.pm - NP / 256) * 256 + wr * 64 + fr, col0 = u.pn * 256 + wc * 32 + 4 * fq;
#pragma unroll
        for (int ai = 0; ai < 2; ++ai)
#pragma unroll
            for (int m = 0; m < 4; ++m) {
                const size_t off = (size_t)(row0 + ai * 128 + m * 16) * DM + col0;
#pragma unroll
                for (int bj = 0; bj < 2; ++bj)
#pragma unroll
                    for (int n = 0; n < 2; ++n) *(f32x4*)(P + off + bj * 128 + n * 16) = acc[ai][bj][m][n];
            }
    }
};
__device__ __forceinline__ f32x4 bf4(u32x2 w) { f32x4 r; r[0] = __uint_as_float(w.x << 16); r[1] = __uint_as_float(w.x & 0xffff0000u); r[2] = __uint_as_float(w.y << 16); r[3] = __uint_as_float(w.y & 0xffff0000u); return r; }
struct EpiBRh {
    static constexpr bool PERM = true;
    const bf16_t* G; bf16_t* MG;
    __device__ __forceinline__ void mid(AccRef acc, const pg8::Unit& u, int b, int wr, int wc, int fr, int fq) const {
        asm volatile("" : "+v"(fr), "+v"(fq));
        const bf16_t* gp = G + ((((size_t)((u.pm * 4 + u.pn) * 3 + b) * 8 + (wr * 4 + wc)) * 16) * 64 + (fq * 16 + fr)) * 8;
        constexpr size_t BST = (size_t)8 * 16 * 64 * 8;
#pragma unroll
        for (int ai = 0; ai < 2; ++ai) {
#pragma unroll
            for (int m = 0; m < 4; ++m)
#pragma unroll
                for (int bj = 0; bj < 2; ++bj) {
                    const bf16_t* q = gp + (size_t)(ai * 8 + m * 2 + bj) * 512;
                    const u32x4 ga = *(const u32x4*)q, gn = *(const u32x4*)(q + BST);
                    const f32x4 a0 = bf4((u32x2){ga.x, ga.y}), a1 = bf4((u32x2){ga.z, ga.w}), n0 = bf4((u32x2){gn.x, gn.y}), n1 = bf4((u32x2){gn.z, gn.w});
#pragma unroll
                    for (int j = 0; j < 4; ++j) { acc[ai][bj][m][0][j] *= a0[j] * __builtin_amdgcn_rcpf(n0[j]); acc[ai][bj][m][1][j] *= a1[j] * __builtin_amdgcn_rcpf(n1[j]); }
                }
            asm volatile("" ::: "memory");
        }
    }
    __device__ __forceinline__ void operator()(AccRef acc, const pg8::Unit& u, int wr, int wc, int fr, int fq) const {
        asm volatile("" : "+v"(fr), "+v"(fq));
        const bf16_t* gp = G + ((((size_t)((u.pm * 4 + u.pn) * 3 + 2) * 8 + (wr * 4 + wc)) * 16) * 64 + (fq * 16 + fr)) * 8;
        const int row0 = u.pm * 256 + wr * 64 + fr, col0 = u.pn * 256 + wc * 32 + 8 * fq;
#pragma unroll
        for (int ai = 0; ai < 2; ++ai) {
#pragma unroll
            for (int m = 0; m < 4; ++m)
#pragma unroll
                for (int bj = 0; bj < 2; ++bj) {
                    const u32x4 ga = *(const u32x4*)(gp + (size_t)(ai * 8 + m * 2 + bj) * 512);
                    const f32x4 v0 = bf4((u32x2){ga.x, ga.y}) * acc[ai][bj][m][0], v1 = bf4((u32x2){ga.z, ga.w}) * acc[ai][bj][m][1];
                    *(u32x4*)(MG + (size_t)(row0 + ai * 128 + m * 16) * DM + col0 + bj * 128) = pack8(v0, v1);
                }
            asm volatile("" ::: "memory");
        }
    }
};
struct EpiMem {
    static constexpr bool PERM = false;
    float* out; bf16_t* MKV;
    __device__ __forceinline__ void operator()(AccRef acc, const pg8::Unit& u, int wr, int wc, int fr, int fq) const {
        asm volatile("" : "+v"(fr), "+v"(fq));
        const int l = u.pn >> 1, kv = u.pn & 1;
        float* ob = out + (kv ? O_PMV : O_PMK) + (size_t)l * 1024 * 256;
        bf16_t* bb = MKV + (size_t)(l * 2 + kv) * 1024 * 256;
        const int row0 = u.pm * 256 + wr * 64 + fr, col0 = wc * 32 + 4 * fq;
#pragma unroll
        for (int ai = 0; ai < 2; ++ai)
#pragma unroll
            for (int m = 0; m < 4; ++m) {
                const size_t off = (size_t)(row0 + ai * 128 + m * 16) * 256 + col0;
#pragma unroll
                for (int bj = 0; bj < 2; ++bj)
#pragma unroll
                    for (int n = 0; n < 2; ++n) { const size_t o = off + bj * 128 + n * 16; const f32x4 v = acc[ai][bj][m][n]; *(f32x4*)(ob + o) = v; u32x2 w; w.x = pk2(v[0], v[1]); w.y = pk2(v[2], v[3]); *(u32x2*)(bb + o) = w; }
            }
    }
};
struct EpiIN {
    static constexpr bool PERM = true;
    bf16_t *XP, *Q, *Kb, *Vb, *XQ, *G; float* out; const float* rope; int l;
    __device__ __forceinline__ void operator()(AccRef acc, const pg8::Unit& u, int wr, int wc, int fr, int fq) const {
        asm volatile("" : "+v"(fr), "+v"(fq));
        const int pn = u.pn;
        const int row0 = u.pm * 256 + wr * 64 + fr;
        const int cl = wc * 32 + 8 * fq;
        const bool ropelane = ((wc & 1) == 0) && (fq < 2);
#pragma unroll
        for (int ai = 0; ai < 2; ++ai)
#pragma unroll
            for (int m = 0; m < 4; ++m) {
                const int row = row0 + ai * 128 + m * 16;
                const bool smp = row >= NP;
                const int b = smp ? ((row - NP) >> 3) : (row >> 12);
                const int t = smp ? ((row - NP) & 7) : (row & 4095);
#pragma unroll
                for (int bj = 0; bj < 2; ++bj) {
                    f32x4 v0 = acc[ai][bj][m][0], v1 = acc[ai][bj][m][1];
                    const int c = cl + 128 * bj;
                    if (pn == 0) {
                        *(u32x4*)(XP + (size_t)row * 256 + c) = pack8(v0, v1);
                        if (smp) { float* o = out + O_SP + ((size_t)(l * DB + b) * 15 + 7 + t) * 256 + c; *(f32x4*)o = v0; *(f32x4*)(o + 4) = v1; }
                        else if (t >= SEQ - 15) { float* o = out + O_PP + ((size_t)(l * NB + b) * 15 + (t - (SEQ - 15))) * 256 + c; *(f32x4*)o = v0; *(f32x4*)(o + 4) = v1; }
                    } else if (pn <= 3) {
                        const bool isv = (pn == 3) && (bj == 1);
                        if (!isv) {
                            f32x4 p0, p1;
#pragma unroll
                            for (int j = 0; j < 4; ++j) { p0[j] = __shfl_xor(v0[j], 16); p1[j] = __shfl_xor(v1[j], 16); }
                            if (ropelane) {
                                const float* tp = rope + (size_t)(smp ? SEQ + t : t) * 16;
                                const f32x4 c0 = *(const f32x4*)tp, c1 = *(const f32x4*)(tp + 4), s0 = *(const f32x4*)(tp + 8), s1 = *(const f32x4*)(tp + 12);
                                const float sg = (fq == 0) ? -1.f : 1.f;
                                v0 = v0 * c0 + p0 * s0 * sg; v1 = v1 * c1 + p1 * s1 * sg;
                            }
                        }
                        if (pn < 3) { *(u32x4*)(Q + (size_t)row * 512 + (pn - 1) * 256 + c) = pack8(v0 * 0.125f, v1 * 0.125f); }
                        else {
                            bf16_t* dst = (bj == 0) ? Kb : Vb;
                            *(u32x4*)(dst + (size_t)row * 128 + cl) = pack8(v0, v1);
                            if (smp) { float* o = out + (bj == 0 ? O_SK : O_SV) + ((size_t)(l * DB + b) * 128 + 120 + t) * 128 + cl; *(f32x4*)o = v0; *(f32x4*)(o + 4) = v1; }
                            else if (t >= SEQ - 128) { float* o = out + (bj == 0 ? O_PK : O_PV) + ((size_t)(l * NB + b) * 128 + (t - (SEQ - 128))) * 128 + cl; *(f32x4*)o = v0; *(f32x4*)(o + 4) = v1; }
                        }
                    } else if (pn == 4) {
                        *(u32x4*)(XQ + (size_t)row * 256 + c) = pack8(v0 * 0.125f, v1 * 0.125f);
                    } else {
#pragma unroll
                        for (int j = 0; j < 4; ++j) { v0[j] = __builtin_amdgcn_rcpf(1.0f + __expf(-v0[j])); v1[j] = __builtin_amdgcn_rcpf(1.0f + __expf(-v1[j])); }
                        const int gb = (pn - 5) >> 2, gpn = (pn - 5) & 3;
                        *(u32x4*)(G + ((((size_t)((u.pm * 4 + gpn) * 3 + gb) * 8 + (wr * 4 + wc)) * 16 + (ai * 8 + m * 2 + bj)) * 64 + (fq * 16 + fr)) * 8) = pack8(v0, v1);
                    }
                }
            }
    }
};

__device__ __forceinline__ void transpose_item(const float* W, int N, int k0, int n0, bf16_t* dst, int ldd, LAS float* scr, int lane) {
#pragma unroll 8
    for (int i = 0; i < 32; ++i) { const int kk = 2 * i + (lane >> 5); scr[kk * 33 + (lane & 31)] = W[(size_t)(k0 + kk) * N + n0 + (lane & 31)]; }
    LDS_WAIT();
    const int c = lane & 7;
#pragma unroll
    for (int j = 0; j < 4; ++j) { const int n = (lane >> 3) + 8 * j; const LAS float* s = scr + (8 * c) * 33 + n;
        u32x4 o; o.x = pk2(s[0 * 33], s[1 * 33]); o.y = pk2(s[2 * 33], s[3 * 33]); o.z = pk2(s[4 * 33], s[5 * 33]); o.w = pk2(s[6 * 33], s[7 * 33]);
        *(u32x4*)(dst + (size_t)n * ldd + 8 * c) = o; }
    LDS_WAIT();
}
struct Job { const float* src; bf16_t* dst; int K, N, ldd, mode; };
__device__ __forceinline__ Job get_job(KP pp, int l, int ty) {
    const Params __attribute__((address_space(4)))& p = *pp;
    unsigned char* wl = p.ws + WS_W + (size_t)l * WL_STRIDE;
    Job j; j.mode = 0;
    switch (ty) {
    case 0: j.src = p.in[10] + (size_t)l * DM * DFF; j.dst = (bf16_t*)(wl + WL_GU1); j.K = DM; j.N = DFF; j.ldd = DM; j.mode = 1; break;
    case 1: j.src = p.in[11] + (size_t)l * DM * DFF; j.dst = (bf16_t*)(wl + WL_GU1); j.K = DM; j.N = DFF; j.ldd = DM; j.mode = 2; break;
    case 2: j.src = p.in[12] + (size_t)l * DFF * DM; j.dst = (bf16_t*)(wl + WL_D1); j.K = DFF; j.N = DM; j.ldd = DFF; break;
    case 3: j.src = p.in[15] + (size_t)l * DM * INC; j.dst = (bf16_t*)(wl + WL_IN); j.K = DM; j.N = INC; j.ldd = DM; break;
    case 4: j.src = p.in[19] + (size_t)l * 256 * DM; j.dst = (bf16_t*)(wl + WL_BR); j.K = 256; j.N = DM; j.ldd = DM; break;
    case 5: j.src = p.in[20] + (size_t)l * 512 * DM; j.dst = (bf16_t*)(wl + WL_BR) + 256; j.K = 512; j.N = DM; j.ldd = DM; break;
    case 6: j.src = p.in[21] + (size_t)l * 256 * DM; j.dst = (bf16_t*)(wl + WL_BR) + 768; j.K = 256; j.N = DM; j.ldd = DM; break;
    case 7: j.src = p.in[22] + (size_t)l * DM * DM; j.dst = (bf16_t*)(wl + WL_O); j.K = DM; j.N = DM; j.ldd = DM; break;
    case 8: j.src = p.in[25] + (size_t)l * DM * DFF; j.dst = (bf16_t*)(wl + WL_GU2); j.K = DM; j.N = DFF; j.ldd = DM; j.mode = 1; break;
    case 9: j.src = p.in[26] + (size_t)l * DM * DFF; j.dst = (bf16_t*)(wl + WL_GU2); j.K = DM; j.N = DFF; j.ldd = DM; j.mode = 2; break;
    case 10: j.src = p.in[27] + (size_t)l * DFF * DM; j.dst = (bf16_t*)(wl + WL_D2); j.K = DFF; j.N = DM; j.ldd = DFF; break;
    case 11: j.src = p.in[8] + (size_t)l * DM * 256; j.dst = (bf16_t*)(p.ws + WS_WMEM) + (size_t)(l * 2 + 0) * 256 * DM; j.K = DM; j.N = 256; j.ldd = DM; break;
    default: j.src = p.in[9] + (size_t)l * DM * 256; j.dst = (bf16_t*)(p.ws + WS_WMEM) + (size_t)(l * 2 + 1) * 256 * DM; j.K = DM; j.N = 256; j.ldd = DM; break;
    }
    return j;
}
__device__ __forceinline__ void prologue_phase(KP pp, LAS unsigned char* lds) {
    const Params __attribute__((address_space(4)))& p = *pp;
    int tid = threadIdx.x; asm volatile("" : "+v"(tid));
    const int lane = tid & 63, wave = tid >> 6;
    const int gw = blockIdx.x * 8 + wave, NGW = gridDim.x * 8;
    LAS float* scr = (LAS float*)(lds + wave * 16384);
    int base = 0;
#pragma nounroll
    for (int l = 0; l < DEPTH; ++l) {
#pragma nounroll
        for (int ty = 0; ty < 13; ++ty) {
            const Job j = get_job(pp, l, ty);
            const int nblk = j.N >> 5, nit = (j.K >> 6) * nblk;
            int it0 = (gw - base) % NGW; if (it0 < 0) it0 += NGW;
            for (int it = it0; it < nit; it += NGW) {
                const int kb = it / nblk, nb = it - kb * nblk, k0 = kb * 64, n0 = nb * 32;
                int drow = n0;
                if (j.mode) drow = 256 * (n0 >> 7) + (n0 & 127) + (j.mode == 2 ? 128 : 0);
                transpose_item(j.src, j.N, k0, n0, j.dst + (size_t)drow * j.ldd + k0, j.ldd, scr, lane);
            }
            base = (base + nit) % NGW;
        }
    }
    const int gt = blockIdx.x * 512 + tid, NGT = gridDim.x * 512;
    float* rope = (float*)(p.ws + WS_ROPE);
    for (int e = gt; e < (SEQ + DSEQ) * 8; e += NGT) {
        const int idx = e >> 3, i = e & 7; const int pos = idx < SEQ ? idx : 8192 + (idx - SEQ);
        const float angf = (float)pos * p.invf[i];
        const double a = (double)angf; const double TWO_PI = 6.283185307179586476925286766559;
        const double kq = __builtin_rint(a / TWO_PI); const double r = a - kq * TWO_PI; const double r2 = r * r;
        double sn = r, cs = 1.0, ts = r, tc = 1.0;
#pragma unroll 1
        for (int n = 1; n <= 15; ++n) { tc = -tc * r2 / (double)((2 * n - 1) * (2 * n)); ts = -ts * r2 / (double)((2 * n) * (2 * n + 1)); cs += tc; sn += ts; }
        rope[(size_t)idx * 16 + i] = (float)cs; rope[(size_t)idx * 16 + 8 + i] = (float)sn;
    }
    { const float* mp = p.in[7]; bf16_t* mb = (bf16_t*)(p.ws + WS_MEMB);
      for (int e = gt; e < 1024 * 1024 / 8; e += NGT) { const f32x4 a = *(const f32x4*)(mp + (size_t)e * 8), b = *(const f32x4*)(mp + (size_t)e * 8 + 4); *(u32x4*)(mb + (size_t)e * 8) = pack8(a, b); } }
    { bf16_t* xb = (bf16_t*)(p.ws + WS_XB); float* X = p.out + O_Y;
      for (int e = gt; e < MROWS * DM / 8; e += NGT) {
          const size_t o = (size_t)e * 8; const float* src = o < (size_t)NP * DM ? p.in[0] + o : p.in[1] + (o - (size_t)NP * DM);
          const f32x4 a = *(const f32x4*)src, b = *(const f32x4*)(src + 4); *(f32x4*)(X + o) = a; *(f32x4*)(X + o + 4) = b; *(u32x4*)(xb + o) = pack8(a, b); } }
}

__device__ __forceinline__ void ln_phase(const float* Z, float* X, bf16_t* XB, const float* g, const float* b, const float* part, int nparts, float cs) {
    int tid = threadIdx.x; asm volatile("" : "+v"(tid));
    const int lane = tid & 63, wave = tid >> 6;
    const int gw = blockIdx.x * 8 + wave, NGW = gridDim.x * 8;
    f32x4 gg[4], bb[4];
#pragma unroll
    for (int j = 0; j < 4; ++j) { gg[j] = *(const f32x4*)(g + 256 * j + 4 * lane); bb[j] = *(const f32x4*)(b + 256 * j + 4 * lane); }
    for (int row = gw; row < MROWS; row += NGW) {
        const f32x4* zr = (const f32x4*)(Z + (size_t)row * DM) + lane;
        f32x4 v[4]; float s = 0.f;
#pragma unroll
        for (int j = 0; j < 4; ++j) v[j] = (f32x4){0.f, 0.f, 0.f, 0.f};
        if (row < NP) {
#pragma unroll
            for (int j = 0; j < 4; ++j) v[j] = zr[64 * j];
        } else {
            const f32x4* xr = (const f32x4*)(X + (size_t)row * DM) + lane;
            f32x4 a[4];
#pragma unroll
            for (int j = 0; j < 4; ++j) a[j] = (f32x4){0.f, 0.f, 0.f, 0.f};
            for (int k = 0; k < nparts; ++k) { const f32x4* pr = (const f32x4*)(part + ((size_t)k * NSMP + (row - NP)) * DM) + lane;
#pragma unroll
                for (int j = 0; j < 4; ++j) a[j] += pr[64 * j]; }
#pragma unroll
            for (int j = 0; j < 4; ++j) v[j] = xr[64 * j] * ALPHA + a[j] * cs;
        }
#pragma unroll
        for (int j = 0; j < 4; ++j) s += (v[j][0] + v[j][1]) + (v[j][2] + v[j][3]);
        const float mean = wave_sum(s) * (1.f / DM); float s2 = 0.f;
#pragma unroll
        for (int j = 0; j < 4; ++j) { v[j] = v[j] - mean; s2 += (v[j][0] * v[j][0] + v[j][1] * v[j][1]) + (v[j][2] * v[j][2] + v[j][3] * v[j][3]); }
        const float rstd = 1.f / sqrtf(wave_sum(s2) * (1.f / DM) + LN_EPS);
        f32x4* xo = (f32x4*)(X + (size_t)row * DM) + lane; u32x2* bo = (u32x2*)(XB + (size_t)row * DM) + lane;
#pragma unroll
        for (int j = 0; j < 4; ++j) { const f32x4 o = v[j] * rstd * gg[j] + bb[j]; xo[64 * j] = o; u32x2 w; w.x = pk2(o[0], o[1]); w.y = pk2(o[2], o[3]); bo[64 * j] = w; }
    }
}

constexpr int KPITCH = 144;
constexpr int VPITCH = 520;
constexpr int LDS_KS = 0, LDS_VT = 256 * KPITCH;
__device__ __forceinline__ int crow(int i, int h) { return (i & 3) + 8 * (i >> 2) + 4 * h; }
__device__ __forceinline__ bf16x8 packrow(const f32x16& x, int s) {
    u32x4 w; w.x = pk2(x[8 * s + 0], x[8 * s + 1]); w.y = pk2(x[8 * s + 2], x[8 * s + 3]); w.z = pk2(x[8 * s + 4], x[8 * s + 5]); w.w = pk2(x[8 * s + 6], x[8 * s + 7]);
    return __builtin_bit_cast(bf16x8, w);
}
#define MFMA32(a, b, c) __builtin_amdgcn_mfma_f32_32x32x16_bf16((a), (b), (c), 0, 0, 0)
template <bool MASK>
__device__ __forceinline__ void attn_qtile(const LAS unsigned char* Ks, const LAS unsigned char* Vts, int c_lo, int c_hi, const bf16_t* qptr, int qi, float m_init, float l_init, bf16_t* optr, bool do_store, int lane) {
    const int r = lane & 31, h = lane >> 5;
    bf16x8 qf[4];
#pragma unroll
    for (int s = 0; s < 4; ++s) qf[s] = *(const bf16x8*)(qptr + 16 * s + 8 * h);
    f32x16 o0, o1;
#pragma unroll
    for (int i = 0; i < 16; ++i) { o0[i] = 0.f; o1[i] = 0.f; }
    float mrun = m_init, lrun = l_init;
#pragma nounroll
    for (int c = c_lo; c < c_hi; ++c) {
        const int kb = 64 * c;
        f32x16 s0, s1;
#pragma unroll
        for (int i = 0; i < 16; ++i) { s0[i] = 0.f; s1[i] = 0.f; }
#pragma unroll
        for (int s = 0; s < 4; ++s) {
            const bf16x8 k0 = *(const LAS bf16x8*)(Ks + (kb + r) * KPITCH + 32 * s + 16 * h);
            const bf16x8 k1 = *(const LAS bf16x8*)(Ks + (kb + 32 + r) * KPITCH + 32 * s + 16 * h);
            s0 = MFMA32(k0, qf[s], s0); s1 = MFMA32(k1, qf[s], s1);
        }
        if (MASK) {
#pragma unroll
            for (int i = 0; i < 16; ++i) { const int j0 = kb + crow(i, h), j1 = j0 + 32;
                if (!(j0 > qi && j0 <= qi + 128)) s0[i] = -INFINITY;
                if (!(j1 > qi && j1 <= qi + 128)) s1[i] = -INFINITY; }
        }
        float cm = fmaxf(s0[0], s1[0]);
#pragma unroll
        for (int i = 1; i < 16; ++i) cm = fmaxf(cm, fmaxf(s0[i], s1[i]));
        cm = fmaxf(cm, __shfl_xor(cm, 32));
        const float mn = fmaxf(mrun, cm);
        const float alpha = __expf(mrun - mn);
        mrun = mn;
        float ps = 0.f;
#pragma unroll
        for (int i = 0; i < 16; ++i) { s0[i] = __expf(s0[i] - mn); s1[i] = __expf(s1[i] - mn); ps += s0[i] + s1[i]; }
        lrun = lrun * alpha + ps;
#pragma unroll
        for (int i = 0; i < 16; ++i) { o0[i] *= alpha; o1[i] *= alpha; }
        const bf16x8 p00 = packrow(s0, 0), p01 = packrow(s0, 1), p10 = packrow(s1, 0), p11 = packrow(s1, 1);
#pragma unroll
        for (int dt = 0; dt < 2; ++dt) {
            const LAS unsigned char* vrow = Vts + (32 * dt + r) * VPITCH + (kb + 4 * h) * 2;
            f32x16 o = dt ? o1 : o0;
#pragma unroll
            for (int tt = 0; tt < 2; ++tt)
#pragma unroll
                for (int s2 = 0; s2 < 2; ++s2) {
                    const s16x4 lo = *(const LAS s16x4*)(vrow + (32 * tt + 16 * s2) * 2);
                    const s16x4 hi = *(const LAS s16x4*)(vrow + (32 * tt + 16 * s2 + 8) * 2);
                    const bf16x8 vf = __builtin_shufflevector(lo, hi, 0, 1, 2, 3, 4, 5, 6, 7);
                    const bf16x8 pf = tt ? (s2 ? p11 : p10) : (s2 ? p01 : p00);
                    o = MFMA32(vf, pf, o);
                }
            if (dt) o1 = o; else o0 = o;
        }
    }
    const float lt = lrun + __shfl_xor(lrun, 32);
    const float inv = 1.0f / lt;
    if (do_store) {
#pragma unroll
        for (int g4 = 0; g4 < 4; ++g4) {
            u32x2 w0, w1;
            w0.x = pk2(o0[4 * g4 + 0] * inv, o0[4 * g4 + 1] * inv); w0.y = pk2(o0[4 * g4 + 2] * inv, o0[4 * g4 + 3] * inv);
            w1.x = pk2(o1[4 * g4 + 0] * inv, o1[4 * g4 + 1] * inv); w1.y = pk2(o1[4 * g4 + 2] * inv, o1[4 * g4 + 3] * inv);
            *(u32x2*)(optr + 8 * g4 + 4 * h) = w0;
            *(u32x2*)(optr + 32 + 8 * g4 + 4 * h) = w1;
        }
    }
}
__device__ __forceinline__ u32x4 ld8_f32(const float* p) { const f32x4 a = *(const f32x4*)p, b = *(const f32x4*)(p + 4); return pack8(a, b); }
__device__ __forceinline__ void put_kv(LAS unsigned char* Ks, LAS unsigned char* Vts, int key, int ch, u32x4 kk, u32x4 vv) {
    *(LAS u32x4*)(Ks + key * KPITCH + ch * 16) = kk;
    LAS unsigned short* vp = (LAS unsigned short*)(Vts + (ch * 8) * VPITCH + key * 2);
    constexpr int VP2 = VPITCH / 2;
    vp[0 * VP2] = (unsigned short)(vv.x & 0xffffu); vp[1 * VP2] = (unsigned short)(vv.x >> 16);
    vp[2 * VP2] = (unsigned short)(vv.y & 0xffffu); vp[3 * VP2] = (unsigned short)(vv.y >> 16);
    vp[4 * VP2] = (unsigned short)(vv.z & 0xffffu); vp[5 * VP2] = (unsigned short)(vv.z >> 16);
    vp[6 * VP2] = (unsigned short)(vv.w & 0xffffu); vp[7 * VP2] = (unsigned short)(vv.w >> 16);
}

template <int W>
__device__ __forceinline__ void pool_rows(const float (&v)[23], bool prompt, int t0, LAS float* dsm, int rbase, int col) {
#pragma unroll
    for (int i = 0; i < 8; ++i) {
        float s = 0.f;
#pragma unroll
        for (int k = 0; k < W; ++k) s += v[15 + i - k];
        const int cnt = prompt ? ((t0 + i + 1) < W ? (t0 + i + 1) : W) : W;
        dsm[(rbase + i) * 256 + col] = s / (float)cnt - v[15 + i];
    }
}
__device__ __forceinline__ void mix_phase(KP pp, int l, LAS unsigned char* lds) {
    const Params __attribute__((address_space(4)))& p = *pp;
    int tid = threadIdx.x; asm volatile("" : "+v"(tid));
    const int lane = tid & 63, wave = __builtin_amdgcn_readfirstlane(tid >> 6);
    const bf16_t* XP = (const bf16_t*)(p.ws + WS_XP); const bf16_t* Q = (const bf16_t*)(p.ws + WS_Q);
    const bf16_t* Kb = (const bf16_t*)(p.ws + WS_K); const bf16_t* Vb = (const bf16_t*)(p.ws + WS_V);
    const bf16_t* XQ = (const bf16_t*)(p.ws + WS_XQ); bf16_t* Y = (bf16_t*)(p.ws + WS_YB);
    LAS unsigned char* Ks = lds + LDS_KS; LAS unsigned char* Vts = lds + LDS_VT;
    const float* sink = p.in[18] + l * 8;
    const int r = lane & 31;
    constexpr int NU = 256 + 256 + 256 + 512 + 544;
    for (int u = blockIdx.x; u < NU; u += gridDim.x) {
        __syncthreads();
        if (u < 256) {
            const int kvh = u & 1, blk = (u >> 1) & 31, b = u >> 6;
            const int jlo = blk == 0 ? 128 : 0;
            const size_t krow0 = (size_t)b * SEQ + (blk - 1) * 128;
            for (int it = tid + jlo * 8; it < 256 * 8; it += 512) { const int key = it >> 3, ch = it & 7;
                const size_t o = (krow0 + key) * 128 + kvh * 64 + ch * 8;
                put_kv(Ks, Vts, key, ch, *(const u32x4*)(Kb + o), *(const u32x4*)(Vb + o)); }
            __syncthreads();
#pragma nounroll
            for (int q2 = 0; q2 < 2; ++q2) {
                const int qt = wave * 2 + q2, g = qt >> 2, i0 = (qt & 3) * 32;
                int c_lo = i0 >= 64 ? 1 : 0, c_hi = i0 >= 64 ? 4 : 3; if (blk == 0) c_lo = 2;
                const size_t row = (size_t)b * SEQ + blk * 128 + i0 + r;
                const int hq = kvh * 4 + g;
                attn_qtile<true>(Ks, Vts, c_lo, c_hi, Q + row * 512 + hq * 64, i0 + r, sink[hq], (lane < 32) ? 1.f : 0.f, Y + row * 1024 + 256 + hq * 64, true, lane);
            }
        } else if (u < 512) {
            const int v = u - 256, head = v & 3, qb = (v >> 2) & 15, b = v >> 6;
            const bf16_t* mk = (const bf16_t*)(p.ws + WS_MEMKV) + (size_t)(l * 2 + 0) * 1024 * 256 + (size_t)b * 256 * 256 + head * 64;
            const bf16_t* mv = (const bf16_t*)(p.ws + WS_MEMKV) + (size_t)(l * 2 + 1) * 1024 * 256 + (size_t)b * 256 * 256 + head * 64;
            for (int it = tid; it < 256 * 8; it += 512) { const int key = it >> 3, ch = it & 7; const size_t o = (size_t)key * 256 + ch * 8;
                put_kv(Ks, Vts, key, ch, *(const u32x4*)(mk + o), *(const u32x4*)(mv + o)); }
            __syncthreads();
            const size_t row = (size_t)b * SEQ + qb * 256 + wave * 32 + r;
            attn_qtile<false>(Ks, Vts, 0, 4, XQ + row * 256 + head * 64, 0, -INFINITY, 0.f, Y + row * 1024 + 768 + head * 64, true, lane);
        } else if (u < 768) {
            const int v = u - 512, kvh = v & 1, b = v >> 1;
            const float* ck = p.in[2] + ((size_t)(l * DB + b) * 128) * 128 + kvh * 64;
            const float* cv = p.in[3] + ((size_t)(l * DB + b) * 128) * 128 + kvh * 64;
            float* ok = p.out + O_SK + ((size_t)(l * DB + b) * 128) * 128 + kvh * 64;
            float* ov = p.out + O_SV + ((size_t)(l * DB + b) * 128) * 128 + kvh * 64;
            for (int it = tid; it < 192 * 8; it += 512) { const int key = it >> 3, ch = it & 7;
                u32x4 kk = (u32x4){0u, 0u, 0u, 0u}, vv = (u32x4){0u, 0u, 0u, 0u};
                if (key < 128) {
                    const size_t o = (size_t)key * 128 + ch * 8;
                    const f32x4 ka = *(const f32x4*)(ck + o), kb2 = *(const f32x4*)(ck + o + 4), va = *(const f32x4*)(cv + o), vb2 = *(const f32x4*)(cv + o + 4);
                    kk = pack8(ka, kb2); vv = pack8(va, vb2);
                    if (key >= 8) { const size_t oo = (size_t)(key - 8) * 128 + ch * 8; *(f32x4*)(ok + oo) = ka; *(f32x4*)(ok + oo + 4) = kb2; *(f32x4*)(ov + oo) = va; *(f32x4*)(ov + oo + 4) = vb2; }
                } else if (key < 136) {
                    const size_t o = ((size_t)NP + b * 8 + (key - 128)) * 128 + kvh * 64 + ch * 8;
                    kk = *(const u32x4*)(Kb + o); vv = *(const u32x4*)(Vb + o);
                }
                put_kv(Ks, Vts, key, ch, kk, vv); }
            __syncthreads();
            if (wave == 0) {
                const int g = r >> 3, t = r & 7, hq = kvh * 4 + g;
                const size_t row = (size_t)NP + b * 8 + t;
                attn_qtile<true>(Ks, Vts, 0, 3, Q + row * 512 + hq * 64, t, sink[hq], (lane < 32) ? 1.f : 0.f, Y + row * 1024 + 256 + hq * 64, true, lane);
            }
        } else if (u < 1280) {
            const int v = u - 768, head = v & 3, b = v >> 2;
            const float* mk = p.in[5] + ((size_t)(l * DB + b) * 256) * 256 + head * 64;
            const float* mv = p.in[6] + ((size_t)(l * DB + b) * 256) * 256 + head * 64;
            for (int it = tid; it < 256 * 8; it += 512) { const int key = it >> 3, ch = it & 7; const size_t o = (size_t)key * 256 + ch * 8;
                put_kv(Ks, Vts, key, ch, ld8_f32(mk + o), ld8_f32(mv + o)); }
            __syncthreads();
            if (wave == 0) {
                const size_t row = (size_t)NP + b * 8 + (r & 7);
                attn_qtile<false>(Ks, Vts, 0, 4, XQ + row * 256 + head * 64, 0, -INFINITY, 0.f, Y + row * 1024 + 768 + head * 64, r < 8, lane);
            }
        } else {
            const int pc = u - 1280;
            LAS float* dsm = (LAS float*)lds;
            const int col = tid & 255, sub = tid >> 8, grp = col >> 6;
#pragma nounroll
            for (int gi = 0; gi < 2; ++gi) {
                const int g8 = sub * 2 + gi; const int R0 = pc * 32 + g8 * 8;
                float v[23]; bool prompt = R0 < NP; int t0 = 0;
                if (prompt) {
                    t0 = R0 & (SEQ - 1);
#pragma unroll
                    for (int k = 0; k < 23; ++k) v[k] = (t0 - 15 + k >= 0) ? bf2f(XP[(size_t)(R0 - 15 + k) * 256 + col]) : 0.f;
                } else {
                    const int sb = (R0 - NP) >> 3;
                    const float* sp = p.in[4] + ((size_t)(l * DB + sb) * 15) * 256 + col;
#pragma unroll
                    for (int k = 0; k < 15; ++k) v[k] = sp[(size_t)k * 256];
#pragma unroll
                    for (int k = 0; k < 8; ++k) v[15 + k] = bf2f(XP[(size_t)(R0 + k) * 256 + col]);
                    float* op = p.out + O_SP + ((size_t)(l * DB + sb) * 15) * 256 + col;
#pragma unroll
                    for (int k = 0; k < 7; ++k) op[(size_t)k * 256] = v[8 + k];
                }
                if (grp == 0) pool_rows<2>(v, prompt, t0, dsm, g8 * 8, col);
                else if (grp == 1) pool_rows<4>(v, prompt, t0, dsm, g8 * 8, col);
                else if (grp == 2) pool_rows<8>(v, prompt, t0, dsm, g8 * 8, col);
                else pool_rows<16>(v, prompt, t0, dsm, g8 * 8, col);
            }
            __syncthreads();
            const float* pm = p.in[16] + ((size_t)(l * 4 + grp) * 64) * 64 + (col & 63);
            float wreg[64];
#pragma unroll
            for (int c = 0; c < 64; ++c) wreg[c] = pm[c * 64];
            const float psc = p.in[17][l * 256 + col];
#pragma nounroll
            for (int rr = 0; rr < 16; ++rr) {
                const int row = sub * 16 + rr;
                const LAS f32x4* dp = (const LAS f32x4*)(dsm + row * 256 + grp * 64);
                float a = 0.f;
#pragma unroll
                for (int c4 = 0; c4 < 16; ++c4) { const f32x4 d = dp[c4]; a += d[0] * wreg[4 * c4] + d[1] * wreg[4 * c4 + 1] + d[2] * wreg[4 * c4 + 2] + d[3] * wreg[4 * c4 + 3]; }
                const unsigned w = pk2(a * psc, 0.f);
                Y[(size_t)(pc * 32 + row) * 1024 + col] = (bf16_t)(w & 0xffffu);
            }
        }
    }
}


#define XB_TMO      128
#define XB_XCNT(j)  (256  + 64 * (j))
#define XB_XSUB(j)  (1280 + 64 * (j))
#define XB_XGEN(j)  (2304 + 64 * (j))
#define XB_TOP      3328
#define XB_TOPGEN   3392
#define XCD_BAR_WORDS 3456
#define XB_SPIN_CAP (1u << 18)
__device__ __forceinline__ unsigned xb_ld(unsigned* p)              { return __hip_atomic_load(p, __ATOMIC_RELAXED, __HIP_MEMORY_SCOPE_AGENT); }
__device__ __forceinline__ unsigned xb_add(unsigned* p, unsigned v) { return __hip_atomic_fetch_add(p, v, __ATOMIC_RELAXED, __HIP_MEMORY_SCOPE_AGENT); }
__device__ __forceinline__ unsigned xb_xcc_id() { return (unsigned)__builtin_amdgcn_s_getreg((3 << 11) | 20) & 0xFu; }
#define XB_SPIN(cond, bar) do { unsigned _sp = 0; while (cond) { __builtin_amdgcn_s_sleep(1); \
    if ((++_sp & 255u) == 0u) { if (xb_ld(&(bar)[XB_TMO])) break; if (_sp > XB_SPIN_CAP) { atomicAdd(&(bar)[XB_TMO], 1u); break; } } } } while (0)
struct XcdBarrier { unsigned* bar; unsigned x; volatile LAS unsigned* st; };
__device__ __forceinline__ XcdBarrier xcd_barrier_post(unsigned* bar, volatile LAS unsigned* st) {
    XcdBarrier b; b.bar = bar; b.x = xb_xcc_id(); b.st = st;
    if (threadIdx.x == 0) (void)xb_add(&bar[XB_XCNT(b.x)], 1u);
    return b;
}
__device__ __forceinline__ void xcd_barrier_complete(unsigned* bar, unsigned x, unsigned& nloc, unsigned& nx) {
    const unsigned G = gridDim.x * gridDim.y * gridDim.z;
    unsigned sum, cnt, mine, sp = 0u;
    for (;;) {
        sum = 0u; cnt = 0u; mine = 0u;
#pragma unroll
        for (unsigned j = 0; j < 16; ++j) { const unsigned c = xb_ld(&bar[XB_XCNT(j)]); sum += c; cnt += (c > 0u) ? 1u : 0u; mine = (j == x) ? c : mine; }
        if (sum == G) break;
        __builtin_amdgcn_s_sleep(1);
        if ((++sp & 255u) == 0u) { if (xb_ld(&bar[XB_TMO])) break; if (sp > XB_SPIN_CAP) { atomicAdd(&bar[XB_TMO], 1u); break; } }
    }
    nloc = mine > 0u ? mine : 1u; nx = cnt > 0u ? cnt : 1u;
}
__device__ __forceinline__ void xcd_barrier(const XcdBarrier& b) {
    asm volatile("s_waitcnt vmcnt(0)" ::: "memory");
    __syncthreads();
    if (threadIdx.x == 0) {
        unsigned* bar = b.bar;
        __builtin_amdgcn_s_waitcnt(0);
        unsigned nloc = b.st[0], nx = b.st[1];
        if (nloc == 0u) { xcd_barrier_complete(bar, b.x, nloc, nx); b.st[0] = nloc; b.st[1] = nx; }
        const unsigned old = xb_add(&bar[XB_XSUB(b.x)], 1u);
        const unsigned gen = old / nloc;
        if (old + 1u == (gen + 1u) * nloc) {
            __builtin_amdgcn_fence(__ATOMIC_RELEASE, "agent");
            asm volatile("s_waitcnt vmcnt(0)" ::: "memory");
            const unsigned og = xb_add(&bar[XB_TOP], 1u);
            const unsigned tg = og / nx;
            if (og + 1u == (tg + 1u) * nx) xb_add(&bar[XB_TOPGEN], 1u);
            else XB_SPIN(xb_ld(&bar[XB_TOPGEN]) == tg, bar);
            __builtin_amdgcn_fence(__ATOMIC_ACQUIRE, "agent");
            xb_add(&bar[XB_XGEN(b.x)], 1u);
            asm volatile("s_waitcnt vmcnt(0)" ::: "memory");
        } else {
            XB_SPIN(xb_ld(&bar[XB_XGEN(b.x)]) == gen, bar);
            __builtin_amdgcn_fence(__ATOMIC_ACQUIRE, "agent");
            asm volatile("s_waitcnt vmcnt(0)" ::: "memory");
        }
    }
    __syncthreads();
}
constexpr int MISC_OFF = 131072 + 320;
constexpr size_t CTL_ZERO_BYTES = 16384;

__global__ void __launch_bounds__(512, 2) fwd_kernel(Params p_unused) {
    extern __shared__ __attribute__((aligned(16))) unsigned char lds_raw[];
    LAS unsigned char* lds = (LAS unsigned char*)lds_raw;
    const int G = gridDim.x, bx = blockIdx.x;
    if (threadIdx.x < 32) ((LAS unsigned*)(lds + MISC_OFF))[threadIdx.x] = 0u;
    __syncthreads();
    unsigned* barw; { KP pp0 = (KP)__builtin_amdgcn_kernarg_segment_ptr(); barw = (unsigned*)pp0->ws; }
    const XcdBarrier bar = xcd_barrier_post(barw, (volatile LAS unsigned*)(lds + MISC_OFF) + 8);
    int ph_lo, ph_hi;
    { KP pp0 = (KP)__builtin_amdgcn_kernarg_segment_ptr(); ph_lo = pp0->ph_lo; ph_hi = pp0->ph_hi; }
    unsigned long long pr_acc = 0, pr_t0 = 0;
#pragma nounroll
    for (int ph = ph_lo; ph < ph_hi; ++ph) {
        if (PROBE_SEL) { pr_t0 = __builtin_amdgcn_s_memrealtime(); }
        if (ph > ph_lo) { if (ph == ph_lo + 1) cg::this_grid().sync(); else xcd_barrier(bar); }
        if (PROBE_SEL) { const unsigned long long t1 = __builtin_amdgcn_s_memrealtime(); if (PROBE_SEL & 4096) pr_acc += t1 - pr_t0; pr_t0 = t1; }
        KP pp = (KP)__builtin_amdgcn_kernarg_segment_ptr(); asm volatile("" : "+s"(pp));
        const Params __attribute__((address_space(4)))& p = *pp;
        if (ph == 0) { prologue_phase(pp, lds); if (PROBE_SEL & 1) pr_acc += __builtin_amdgcn_s_memrealtime() - pr_t0; continue; }
        float* X = p.out + O_Y;
        bf16_t* XB = (bf16_t*)(p.ws + WS_XB); float* Z = (float*)(p.ws + WS_Z);
        bf16_t* ACT = (bf16_t*)(p.ws + WS_ACT);
        const int l = (ph - 1) / 11, sp = (ph - 1) % 11;
        unsigned char* wl = p.ws + WS_W + (size_t)l * WL_STRIDE;
        if (sp == 0 || sp == 8) {
            pg8::Gemm g{XB, (const bf16_t*)(wl + (sp == 0 ? WL_GU1 : WL_GU2)), MROWS, 2 * DFF, DM, DM, DM};
            pg8::StaticOrder S; S.init(MROWS, 2 * DFF, G, bx);
            EpiGU E{ACT};
            pg8::gemm_run<EpiGU, pg8::StaticOrder>(lds, g, S, E);
            if (ph == 1 && bx >= G - 32) {
                pg8::Gemm g2{(const bf16_t*)(p.ws + WS_MEMB), (const bf16_t*)(p.ws + WS_WMEM), 1024, 2048, DM, DM, DM};
                pg8::StaticOrder S2; S2.init(1024, 2048, 32, bx - (G - 32));
                EpiMem E2{p.out, (bf16_t*)(p.ws + WS_MEMKV)};
                pg8::gemm_run<EpiMem, pg8::StaticOrder>(lds, g2, S2, E2);
            }
        } else if (sp == 1 || sp == 9 || sp == 6) {
            const bf16_t* Aop = sp == 6 ? (const bf16_t*)(p.ws + WS_MG) : ACT;
            const bf16_t* Bop = (const bf16_t*)(wl + (sp == 6 ? WL_O : (sp == 1 ? WL_D1 : WL_D2)));
            const int kdim = sp == 6 ? DM : DFF, nsplit = kdim / 256;
            {
                pg8::Gemm g{Aop, Bop, NP, DM, kdim, kdim, kdim};
                pg8::StaticOrder S; S.init(NP, DM, G, bx);
                EpiD E{X, Z, sp == 6 ? 1.0f : 0.5f};
                pg8::gemm_run<EpiD, pg8::StaticOrder>(lds, g, S, E);
            }
            if (bx < 16 * nsplit) {
                const int ks = bx >> 4, un = bx & 15;
                pg8::Gemm g{Aop + ks * 256, Bop + ks * 256, MROWS, DM, 256, kdim, kdim};
                pg8::SingleOrder S1{{NP / 256 + (un >> 2), un & 3}};
                EpiPart E{(float*)(p.ws + (sp == 6 ? WS_PART_O : WS_PART_D)) + (size_t)ks * NSMP * DM};
                pg8::gemm_run<EpiPart, pg8::SingleOrder>(lds, g, S1, E);
            }
        } else if (sp == 2 || sp == 7 || sp == 10) {
            const int gi = sp == 2 ? 13 : (sp == 7 ? 23 : 28);
            ln_phase(Z, X, XB, p.in[gi] + l * DM, p.in[gi + 1] + l * DM, (const float*)(p.ws + (sp == 7 ? WS_PART_O : WS_PART_D)), sp == 7 ? DM / 256 : DFF / 256, sp == 7 ? 1.0f : 0.5f);
        } else if (sp == 3) {
            pg8::Gemm g{XB, (const bf16_t*)(wl + WL_IN), MROWS, INC, DM, DM, DM};
            pg8::StaticOrder S; S.init(MROWS, INC, G, bx);
            EpiIN E{(bf16_t*)(p.ws + WS_XP), (bf16_t*)(p.ws + WS_Q), (bf16_t*)(p.ws + WS_K), (bf16_t*)(p.ws + WS_V), (bf16_t*)(p.ws + WS_XQ), (bf16_t*)(p.ws + WS_G), p.out, (const float*)(p.ws + WS_ROPE), l};
            pg8::gemm_run<EpiIN, pg8::StaticOrder>(lds, g, S, E);
        } else if (sp == 4) {
            mix_phase(pp, l, lds);
        } else {
            pg8::Gemm g{(const bf16_t*)(p.ws + WS_YB), (const bf16_t*)(wl + WL_BR), MROWS, DM, DM, DM, DM};
            pg8::TailOrder S; S.S.init(NP, DM, G, bx); S.c = bx;
            EpiBRh E{(const bf16_t*)(p.ws + WS_G), (bf16_t*)(p.ws + WS_MG)};
            f32x4 acc[2][2][4][2];
            pg8::gemm_phase<EpiBRh, pg8::TailOrder, true, true>(lds, g, S, E, acc, false);
        }
        if (PROBE_SEL) { if ((PROBE_SEL >> (1 + sp)) & 1) pr_acc += __builtin_amdgcn_s_memrealtime() - pr_t0; }
    }
    if (PROBE_SEL) { if (bx == 0 && threadIdx.x == 0) { const unsigned long long te = __builtin_amdgcn_s_memrealtime() + 8ull * pr_acc; while (__builtin_amdgcn_s_memrealtime() < te) __builtin_amdgcn_s_sleep(8); } }
}

extern "C" void kernel_launch(void* const* d_in, const int* in_sizes, int n_in, void* d_out, int out_size, void* d_ws, size_t ws_size, hipStream_t stream) {
    static int grid = 0;
    if (grid == 0) {
        if (n_in != 30 || (size_t)out_size != O_END || ws_size < WS_END) { fprintf(stderr, "kernel_launch: unexpected shapes: n_in %d out %d ws %zu (need %zu)\n", n_in, out_size, ws_size, (size_t)WS_END); grid = -1; return; }
        int dev = 0, cus = 0, per_cu = 0;
        hipGetDevice(&dev); hipDeviceGetAttribute(&cus, hipDeviceAttributeMultiprocessorCount, dev);
        if (hipFuncSetAttribute((const void*)fwd_kernel, hipFuncAttributeMaxDynamicSharedMemorySize, LDS_BYTES) != hipSuccess) { fprintf(stderr, "kernel_launch: hipFuncSetAttribute failed\n"); grid = -1; return; }
        hipOccupancyMaxActiveBlocksPerMultiprocessor(&per_cu, (const void*)fwd_kernel, 512, LDS_BYTES);
        (void)hipGetLastError();
        if (per_cu < 1) { fprintf(stderr, "kernel_launch: occupancy query says %d blocks per CU\n", per_cu); per_cu = 1; }
        grid = cus;
    }
    if (grid < 0) return;
    if (hipMemsetAsync(d_ws, 0, CTL_ZERO_BYTES, stream) != hipSuccess) { fprintf(stderr, "kernel_launch: memset failed\n"); return; }
    Params p{};
    for (int i = 0; i < 30; ++i) p.in[i] = (const float*)d_in[i];
    p.out = (float*)d_out; p.ws = (unsigned char*)d_ws;
    for (int i = 0; i < 8; ++i) p.invf[i] = powf(500000.0f, -(float)i * 0.125f);
#if MK_MULTI
    for (int ph = 0; ph < NPHASE; ++ph) { p.ph_lo = ph; p.ph_hi = ph + 1; hipLaunchKernelGGL(fwd_kernel, dim3(grid), dim3(512), LDS_BYTES, stream, p); }
#else
    p.ph_lo = 0; p.ph_hi = NPHASE;
    void* args[] = {&p};
    hipError_t e = hipLaunchCooperativeKernel((const void*)fwd_kernel, dim3(grid), dim3(512), args, LDS_BYTES, stream);
    if (e != hipSuccess) fprintf(stderr, "kernel_launch: cooperative launch failed: %s (grid %d)\n", hipGetErrorString(e), grid);
#endif
}
```
